# Optimizing an MI355X kernel written in HIP

```python
import jax, jax.numpy as jnp
from jax import lax
import numpy as np

D_MODEL = 1024
BATCH = 16
SEQ = 2048
DEPTH = 2
DEC_BATCH = 32
DEC_SEQ = 64
PAST_LEN = 4096

CHUNK = 64
GMLP_CHUNK = 128
GMLP_GROUPS = 4
GMLP_WIDTH = D_MODEL
GMLP_GROUP_DIM = GMLP_WIDTH // GMLP_GROUPS
HGRN_EXPAND = 128
HGRN_HEADS = D_MODEL // HGRN_EXPAND
HGRN_DK = HGRN_EXPAND
HGRN_DV = D_MODEL // HGRN_HEADS
HGRN_QK_WIDTH = HGRN_HEADS * HGRN_DK
HGRN_WIDTH = HGRN_HEADS * HGRN_DV
HGRN_BLOCK = 16
N_BRANCH = 2
IN_SIZES = (GMLP_WIDTH, GMLP_WIDTH, GMLP_WIDTH, HGRN_QK_WIDTH, HGRN_QK_WIDTH, HGRN_WIDTH, HGRN_WIDTH, D_MODEL, D_MODEL)
IN_COLS = sum(IN_SIZES)
EPS = 1e-6

kernel_name = "gmlp_hgrn2_gated_streaming_step"


def rms_norm(x, g):
    xf = x.astype(jnp.float32)
    r = lax.rsqrt(jnp.mean(xf * xf, axis=-1, keepdims=True) + EPS)
    return (xf * r).astype(x.dtype) * g


def layer_norm(x, g, b):
    xf = x.astype(jnp.float32)
    mu = jnp.mean(xf, axis=-1, keepdims=True)
    var = jnp.mean(jnp.square(xf - mu), axis=-1, keepdims=True)
    return ((xf - mu) * lax.rsqrt(var + EPS)).astype(x.dtype) * g + b


def gmlp_spatial(u, v, w_s, b_s):
    B, T, _ = v.shape
    n = -(-T // GMLP_CHUNK)
    pad = n * GMLP_CHUNK - T
    vp = jnp.pad(v, ((0, 0), (0, pad), (0, 0))).reshape(B, n, GMLP_CHUNK, GMLP_GROUPS, GMLP_GROUP_DIM)
    mask = jnp.tril(jnp.ones((GMLP_CHUNK, GMLP_CHUNK), dtype=bool))
    w = jnp.where(mask[None], w_s, jnp.zeros_like(w_s))
    s = jnp.einsum('gts,bnsgc->bntgc', w, vp) + b_s.T[None, None, :, :, None]
    s = s.reshape(B, n * GMLP_CHUNK, GMLP_WIDTH)[:, :T]
    return u * s


def hgrn2_recurrence(q, k, i, log_f, s0):
    B, T = q.shape[:2]
    n = -(-T // HGRN_BLOCK)
    pad = n * HGRN_BLOCK - T

    def blocks(a):
        a = jnp.pad(a, ((0, 0), (0, pad), (0, 0), (0, 0)))
        return a.reshape(B, n, HGRN_BLOCK, a.shape[2], a.shape[3]).transpose(1, 0, 3, 2, 4)

    qb, kb, ib, fb = blocks(q), blocks(k), blocks(i), blocks(log_f)
    mask = jnp.tril(jnp.ones((HGRN_BLOCK, HGRN_BLOCK), dtype=bool))[None, None, :, :, None]

    def step(S, blk):
        qc, kc, ic, fc = blk
        b = jnp.cumsum(fc, axis=2)
        b_last = b[:, :, -1:, :]
        o_inter = jnp.einsum('bhtk,bhkv->bhtv', qc * jnp.exp(b), S)
        rel = jnp.where(mask, b[:, :, :, None, :] - b[:, :, None, :, :], -jnp.inf)
        a = jnp.einsum('bhtk,bhsk,bhtsk->bhts', qc, kc, jnp.exp(rel))
        o_intra = jnp.einsum('bhts,bhsv->bhtv', a, ic)
        S_new = jnp.exp(b_last[:, :, 0, :])[..., None] * S + jnp.einsum('bhsk,bhsv->bhkv', kc * jnp.exp(b_last - b), ic)
        return S_new, o_inter + o_intra

    S, o = lax.scan(step, s0, (qb, kb, ib, fb))
    o = o.transpose(1, 0, 3, 2, 4).reshape(B, n * HGRN_BLOCK, HGRN_HEADS, HGRN_DV)[:, :T]
    return o, S


def trunk_layer(x, c, s0, lb, w_ada, b_ada, norm_g, w_in, ln_v_g, ln_v_b, w_s, b_s, gnorm_g, w_pa, w_pb, w_o):
    B, T, _ = x.shape
    mod = (jax.nn.silu(c) @ w_ada + b_ada)[:, None, :]
    shift, scale, gate = jnp.split(mod, 3, axis=-1)
    h = rms_norm(x, norm_g) * (1 + scale) + shift
    proj = h @ w_in
    edges, acc = [], 0
    for s in IN_SIZES[:-1]:
        acc += s
        edges.append(acc)
    u, v, z_a, q, f, i, z_b, g_a, g_b = jnp.split(proj, edges, axis=-1)

    u = jax.nn.gelu(u)
    v = layer_norm(jax.nn.gelu(v), ln_v_g, ln_v_b)
    y_a = gmlp_spatial(u, v, w_s, b_s) * jax.nn.silu(z_a)

    qh = jax.nn.silu(q).astype(jnp.float32).reshape(B, T, HGRN_HEADS, HGRN_DK)
    zf = f.astype(jnp.float32).reshape(B, T, HGRN_HEADS, HGRN_DK)
    lbh = lb.reshape(HGRN_HEADS, HGRN_DK)
    log_f = jnp.logaddexp(jnp.log(lbh), jnp.log1p(-lbh) + jax.nn.log_sigmoid(zf))
    k = (1.0 - lbh) * jax.nn.sigmoid(-zf)
    ih = i.astype(jnp.float32).reshape(B, T, HGRN_HEADS, HGRN_DV)
    o, s_new = hgrn2_recurrence(qh, k, ih, log_f, s0.astype(jnp.float32))
    o = rms_norm(o.astype(x.dtype), gnorm_g.reshape(HGRN_HEADS, HGRN_DV)).reshape(B, T, HGRN_WIDTH)
    y_b = o * jax.nn.silu(z_b)

    m = jax.nn.sigmoid(g_a) * (y_a @ w_pa) + jax.nn.sigmoid(g_b) * (y_b @ w_pb)
    x = x + gate * (m @ w_o)
    return x, s_new.astype(x.dtype), v


def setup_inputs(seed: int = 0) -> dict:
    key = jax.random.key(seed)
    ks = jax.random.split(key, 24)
    nrm = jax.random.normal
    D = D_MODEL
    return {
        "x_prompt": nrm(ks[0], (BATCH, SEQ, D), jnp.float32),
        "x_sample": nrm(ks[1], (DEC_BATCH, DEC_SEQ, D), jnp.float32),
        "state_hgrn": 0.5 * nrm(ks[2], (DEPTH, DEC_BATCH, HGRN_HEADS, HGRN_DK, HGRN_DV), jnp.float32),
        "c_prompt": nrm(ks[3], (BATCH, D), jnp.float32),
        "c_sample": nrm(ks[4], (DEC_BATCH, D), jnp.float32),
        "w_ada": 0.5 * D ** -0.5 * nrm(ks[5], (DEPTH, D, 3 * D), jnp.float32),
        "b_ada": 0.01 * nrm(ks[6], (DEPTH, 3 * D), jnp.float32),
        "norm_g": 1.0 + 0.05 * nrm(ks[7], (DEPTH, D), jnp.float32),
        "w_in": D ** -0.5 * nrm(ks[8], (DEPTH, D, IN_COLS), jnp.float32),
        "ln_v_g": 1.0 + 0.05 * nrm(ks[9], (DEPTH, GMLP_WIDTH), jnp.float32),
        "ln_v_b": 0.01 * nrm(ks[10], (DEPTH, GMLP_WIDTH), jnp.float32),
        "w_s": 0.5 * GMLP_CHUNK ** -0.5 * nrm(ks[11], (DEPTH, GMLP_GROUPS, GMLP_CHUNK, GMLP_CHUNK), jnp.float32),
        "b_s": 1.0 + 0.1 * nrm(ks[12], (DEPTH, GMLP_GROUPS, GMLP_CHUNK), jnp.float32),
        "lb_raw": nrm(ks[13], (DEPTH, HGRN_QK_WIDTH), jnp.float32),
        "gnorm_g": 1.0 + 0.05 * nrm(ks[14], (DEPTH, HGRN_WIDTH), jnp.float32),
        "w_pa": GMLP_WIDTH ** -0.5 * nrm(ks[15], (DEPTH, GMLP_WIDTH, D), jnp.float32),
        "w_pb": HGRN_WIDTH ** -0.5 * nrm(ks[16], (DEPTH, HGRN_WIDTH, D), jnp.float32),
        "w_o": D ** -0.5 * nrm(ks[17], (DEPTH, D, D), jnp.float32),
        "final_g": 1.0 + 0.05 * nrm(ks[18], (D,), jnp.float32),
    }


def reference(x_prompt, x_sample, state_hgrn, c_prompt, c_sample, w_ada, b_ada, norm_g, w_in, ln_v_g, ln_v_b,
              w_s, b_s, lb_raw, gnorm_g, w_pa, w_pb, w_o, final_g):
    lbs = jnp.cumsum(jax.nn.softmax(lb_raw.astype(jnp.float32), axis=0), axis=0)
    lbs = lbs - lbs[0:1]
    xp, xs = x_prompt, x_sample
    s_zero = jnp.zeros((x_prompt.shape[0], HGRN_HEADS, HGRN_DK, HGRN_DV), jnp.float32)
    sp_list, ss_list, vs_list = [], [], []
    for l in range(DEPTH):
        wl = (w_ada[l], b_ada[l], norm_g[l], w_in[l], ln_v_g[l], ln_v_b[l], w_s[l], b_s[l], gnorm_g[l],
              w_pa[l], w_pb[l], w_o[l])
        xp, sp, _ = trunk_layer(xp, c_prompt, s_zero, lbs[l], *wl)
        xs, ss, vs = trunk_layer(xs, c_sample, state_hgrn[l], lbs[l], *wl)
        sp_list.append(sp)
        ss_list.append(ss)
        vs_list.append(vs)
    y_prompt = rms_norm(xp, final_g)
    y_sample = rms_norm(xs, final_g)
    new_state_hgrn_prompt = jnp.stack(sp_list)
    new_state_hgrn_sample = jnp.stack(ss_list)
    new_v_gmlp_sample = jnp.stack(vs_list)
    return (y_prompt, y_sample, new_state_hgrn_prompt, new_state_hgrn_sample, new_v_gmlp_sample)
```

```cpp
#include <hip/hip_runtime.h>
#include <hip/hip_cooperative_groups.h>
#include <cstdio>
#include <cstdint>
namespace cg = cooperative_groups;

#ifndef MK_ONE_LAUNCH
#define MK_ONE_LAUNCH 1
#endif

#define LAS __attribute__((address_space(3)))
typedef unsigned short bf16_t;
typedef short bf16x8 __attribute__((ext_vector_type(8)));
typedef float f32x4 __attribute__((ext_vector_type(4)));
typedef float f32x2 __attribute__((ext_vector_type(2)));
typedef unsigned u32x4 __attribute__((ext_vector_type(4)));
typedef unsigned u32x2 __attribute__((ext_vector_type(2)));
typedef _Float16 f16x2 __attribute__((ext_vector_type(2)));

constexpr int D = 1024, MP = 32768, MS = 2048, M = MP + MS, NCOND = 48, NIN = 9216;
constexpr int NB_COLS = 5120, NA_COLS = 4096;
constexpr float EPS = 1e-6f;
constexpr size_t OUT_Y = 0, OUT_SP = (size_t)M * D, OUT_SS = OUT_SP + (size_t)2 * 16 * 8 * 16384, OUT_VS = OUT_SS + (size_t)2 * 32 * 8 * 16384;
constexpr size_t BUF_BYTES = (size_t)M * D * 2;
constexpr size_t WS_WIN = 0;
constexpr size_t WS_WPA = WS_WIN + (size_t)2 * NIN * D * 2;
constexpr size_t WS_WPB = WS_WPA + (size_t)2 * D * D * 2;
constexpr size_t WS_WO = WS_WPB + (size_t)2 * D * D * 2;
constexpr size_t WS_MOD = WS_WO + (size_t)2 * D * D * 2;
constexpr size_t WS_WTP = WS_MOD + (size_t)2 * NCOND * 3 * D * 4;
constexpr size_t WS_STATS = WS_WTP + (size_t)2 * 4 * 16384 * 4;
constexpr size_t WS_BUF = (WS_STATS + (size_t)M * 16 * 2 * 4 + 4095) & ~(size_t)4095;
constexpr size_t WS_BAR = WS_BUF + 6 * BUF_BYTES;
constexpr size_t WS_END = WS_BAR + 256;
constexpr int LDS_BYTES = 131072 + 4096;

struct Params {
    const float *x_prompt, *x_sample, *state_hgrn, *c_prompt, *c_sample, *w_ada, *b_ada, *norm_g, *w_in, *ln_v_g, *ln_v_b, *w_s, *b_s, *lb_raw, *gnorm_g, *w_pa, *w_pb, *w_o, *final_g;
    float* out; unsigned char* ws;
    int ph_lo, ph_hi;
};

typedef const Params __attribute__((address_space(4))) CParams;
typedef __bf16 bf16x2_t __attribute__((ext_vector_type(2)));
__device__ __forceinline__ unsigned cvt_pk_bf16(float lo, float hi) { const f32x2 v = {lo, hi}; const bf16x2_t h = __builtin_convertvector(v, bf16x2_t); return __builtin_bit_cast(unsigned, h); }
__device__ __forceinline__ float bf_lo(unsigned u) { return __uint_as_float(u << 16); }
__device__ __forceinline__ float bf_hi(unsigned u) { return __uint_as_float(u & 0xffff0000u); }
__device__ __forceinline__ unsigned pk_f16(float a, float b) { f16x2 h; h.x = (_Float16)a; h.y = (_Float16)b; return __builtin_bit_cast(unsigned, h); }
__device__ __forceinline__ float f16_lo(unsigned u) { f16x2 h = __builtin_bit_cast(f16x2, u); return (float)h.x; }
__device__ __forceinline__ float f16_hi(unsigned u) { f16x2 h = __builtin_bit_cast(f16x2, u); return (float)h.y; }
__device__ __forceinline__ float fsigmoid(float x) { return __builtin_amdgcn_rcpf(1.0f + __expf(-x)); }
__device__ __forceinline__ float fsilu(float x) { return x * fsigmoid(x); }
__device__ __forceinline__ float fgelu(float x) { return x * fsigmoid(1.5957691216057308f * (x + 0.044715f * x * x * x)); }
__device__ __forceinline__ float wave_sum(float v) {
#pragma unroll
    for (int o = 1; o < 64; o <<= 1) v += __shfl_xor(v, o);
    return v;
}
__device__ __forceinline__ int otid() { int t = threadIdx.x; asm volatile("" : "+v"(t)); return t; }
__device__ __forceinline__ int obid() { int b = blockIdx.x; asm volatile("" : "+s"(b)); return b; }
__device__ __forceinline__ int ogrid() { int g = gridDim.x; asm volatile("" : "+s"(g)); return g; }
__device__ __forceinline__ float xrow16_sum(float x) {
    auto s = __builtin_amdgcn_permlane16_swap(__float_as_uint(x), __float_as_uint(x), false, false);
    x = __uint_as_float(s[0]) + __uint_as_float(s[1]);
    auto t = __builtin_amdgcn_permlane32_swap(__float_as_uint(x), __float_as_uint(x), false, false);
    return __uint_as_float(t[0]) + __uint_as_float(t[1]);
}
template <int CTRL> __device__ __forceinline__ float dpp_mov(float x) { return __builtin_bit_cast(float, __builtin_amdgcn_mov_dpp(__builtin_bit_cast(int, x), CTRL, 0xf, 0xf, true)); }
__device__ __forceinline__ float row16_sum(float x) {
    x += dpp_mov<0xB1>(x); x += dpp_mov<0x4E>(x); x += dpp_mov<0x124>(x); x += dpp_mov<0x128>(x); return x;
}
__device__ __forceinline__ int cond_of_row(int r) { return r < MP ? (r >> 11) : 16 + ((r - MP) >> 6); }

namespace pg8 {
constexpr int BM = 256, BK = 64, HALF = 128, HTB = HALF * BK * 2, STAGE_BYTES = 8 * HTB, NXCD = 8, WGM = 8;
__host__ __device__ __forceinline__ int lds_byte(int r, int c) { const int st = (r >> 4) * 2 + (c >> 5), rr = r & 15, cc = c & 31, ob = rr * 64 + cc * 2; return st * 1024 + (ob ^ (((ob >> 9) & 1) << 5)); }
__host__ __device__ __forceinline__ void stage_rc(int b, int& R, int& C) { const int st = b / 1024, sb = b % 1024, swz = sb ^ (((sb >> 9) & 1) << 5); R = (st >> 1) * 16 + swz / 64; C = (st & 1) * 32 + (swz % 64) / 2; }
__host__ __device__ __forceinline__ int perm32(int rho) { const int n = rho >> 4, i = rho & 15; return 8 * (i >> 2) + 4 * n + (i & 3); }
struct Unit { int pm, pn; };
struct Gemm { const bf16_t* A; const bf16_t* Bt; int M, N, K; };
struct StaticOrder {
    int nM, nN, nwg, G, c;
    __host__ __device__ void init(int M_, int N_, int G_, int c_) { nM = M_ / BM; nN = N_ / BM; nwg = nM * nN; G = G_; c = c_; }
    __host__ __device__ bool next(int i, Unit& u) const {
        const long L = (long)i * G + c; if (L >= nwg) return false;
        int wgid = (int)L; { const int q = nwg / NXCD, r = nwg % NXCD, xcd = wgid % NXCD, off = wgid / NXCD; wgid = (xcd < r ? xcd * (q + 1) : r * (q + 1) + (xcd - r) * q) + off; }
        const int nig = WGM * nN, gid = wgid / nig, fm = gid * WGM, gsz = (nM - fm) < WGM ? (nM - fm) : WGM;
        u.pm = fm + ((wgid % nig) % gsz); u.pn = (wgid % nig) / gsz; return true;
    }
    __device__ __forceinline__ void a_ready(const Unit&) const {}
    __device__ __forceinline__ void done(const Unit&) const {}
};

template <class Epi, class Sched, bool ALIGN_EPI = false, bool SP2 = false>
__device__ __forceinline__ void gemm_phase(LAS unsigned char* lds, const Gemm g, const Sched& S, const Epi& E) {
    const int tid = otid(), wid = __builtin_amdgcn_readfirstlane(tid >> 6), lane = tid & 63, wr = wid >> 2, wc = wid & 3, fr = lane & 15, fq = lane >> 4;
    const int K = g.K, nt = K / BK;
    unsigned voffA[2], voffB[2];
#pragma unroll
    for (int i = 0; i < 2; ++i) { int R, C; stage_rc(tid * 16 + i * 8192, R, C); const int Rb = Epi::PERM ? ((R & ~31) + perm32(R & 31)) : R;
        voffA[i] = (unsigned)(R * K + C) * 2u; voffB[i] = (unsigned)(Rb * K + C) * 2u; }
    const size_t kstep = (size_t)(BK * 2);
    const size_t hstep = (size_t)HALF * K * 2;
    const size_t tstep = 2 * hstep;
    const unsigned ldsw = (unsigned)wid * 1024u;
    const int aoff = lds_byte(wr * 64 + fr, fq * 8), boff = lds_byte(wc * 32 + fr, fq * 8);
#define PG8_SA(b, h) (((b) * 2 + (h)) * HTB)
#define PG8_SB(b, h) ((4 + (b) * 2 + (h)) * HTB)
#define PG8_STAGE(bufoff, gbase, voff) do { _Pragma("unroll") for (int _i = 0; _i < 2; ++_i) \
        __builtin_amdgcn_global_load_lds((const unsigned*)((const char*)(gbase) + (voff)[_i]), (LAS unsigned*)(lds + (bufoff) + ldsw + _i * 8192), 16, 0, 0); } while (0)
#define PG8_LDA(dst, b, h) do { _Pragma("unroll") for (int m = 0; m < 4; ++m) _Pragma("unroll") for (int k = 0; k < 2; ++k) dst[m][k] = *(const LAS bf16x8*)(lds + PG8_SA(b, h) + aoff + m * 2048 + k * 1024); } while (0)
#define PG8_LDB(dst, b, h) do { _Pragma("unroll") for (int n = 0; n < 2; ++n) _Pragma("unroll") for (int k = 0; k < 2; ++k) dst[n][k] = *(const LAS bf16x8*)(lds + PG8_SB(b, h) + boff + n * 2048 + k * 1024); } while (0)
#define PG8_MMA(ai, bj, At, Bt) do { __builtin_amdgcn_s_setprio(1); _Pragma("unroll") for (int m = 0; m < 4; ++m) _Pragma("unroll") for (int n = 0; n < 2; ++n) _Pragma("unroll") for (int k = 0; k < 2; ++k) \
        acc[ai][bj][m][n] = __builtin_amdgcn_mfma_f32_16x16x32_bf16(Bt[n][k], At[m][k], acc[ai][bj][m][n], 0, 0, 0); __builtin_amdgcn_s_setprio(0); } while (0)
#define PG8_WAIT_V(n) asm volatile("s_waitcnt vmcnt(" #n ")" ::: "memory")
#define PG8_WAIT_L(n) asm volatile("s_waitcnt lgkmcnt(" #n ")" ::: "memory")
#define PG8_BAR __builtin_amdgcn_s_barrier()
#define PG8_SCHED __builtin_amdgcn_sched_barrier(0)
    Unit cur, nxt; int ui = 0;
    if (!S.next(0, cur)) return;
    f32x4 acc[2][2][4][2];
#pragma unroll
    for (int a = 0; a < 2; ++a)
#pragma unroll
        for (int b = 0; b < 2; ++b)
#pragma unroll
            for (int m = 0; m < 4; ++m)
#pragma unroll
                for (int n = 0; n < 2; ++n) acc[a][b][m][n] = (f32x4){0.f, 0.f, 0.f, 0.f};
    bf16x8 At[4][2], B0[2][2], B1[2][2];
    const char* cA = (const char*)g.A + (size_t)cur.pm * tstep; const char* cB = (const char*)g.Bt + (size_t)cur.pn * tstep;
    S.a_ready(cur);
    if constexpr (SP2) {
        PG8_STAGE(PG8_SB(0, 0), cB, voffB); PG8_STAGE(PG8_SB(0, 1), cB + hstep, voffB); PG8_STAGE(PG8_SA(0, 0), cA, voffA); PG8_STAGE(PG8_SA(0, 1), cA + hstep, voffA);
        if (wr == 1) PG8_BAR;
        PG8_WAIT_V(2); PG8_BAR;
        PG8_STAGE(PG8_SB(1, 0), cB + kstep, voffB); PG8_STAGE(PG8_SA(1, 0), cA + kstep, voffA); PG8_STAGE(PG8_SB(1, 1), cB + hstep + kstep, voffB);
        PG8_WAIT_V(6); PG8_BAR;
    } else {
        PG8_STAGE(PG8_SB(0, 0), cB, voffB); PG8_STAGE(PG8_SA(0, 0), cA, voffA); PG8_STAGE(PG8_SB(0, 1), cB + hstep, voffB); PG8_STAGE(PG8_SA(0, 1), cA + hstep, voffA);
        if (wr == 1) PG8_BAR;
        PG8_WAIT_V(4); PG8_BAR;
        PG8_STAGE(PG8_SB(1, 0), cB + kstep, voffB); PG8_STAGE(PG8_SA(1, 0), cA + kstep, voffA); PG8_STAGE(PG8_SB(1, 1), cB + hstep + kstep, voffB);
        PG8_WAIT_V(6); PG8_BAR;
    }
    for (;;) {
        const bool has_next = S.next(ui + 1, nxt);
        const char* nA = has_next ? (const char*)g.A + (size_t)nxt.pm * tstep : cA; const char* nB = has_next ? (const char*)g.Bt + (size_t)nxt.pn * tstep : cB;
        for (int t = 0; t < nt; t += 2) {
            const bool last = (t == nt - 2);
            const char* a1 = cA + (size_t)(t + 1) * kstep;
            const char* a2 = last ? nA : cA + (size_t)(t + 2) * kstep; const char* b2 = last ? nB : cB + (size_t)(t + 2) * kstep;
            const char* a3 = a2 + kstep; const char* b3 = b2 + kstep;
            if (last && has_next) S.a_ready(nxt);
            if constexpr (SP2) {
            PG8_LDB(B0, 0, 0); PG8_LDB(B1, 0, 1); PG8_SCHED; PG8_LDA(At, 0, 0); PG8_STAGE(PG8_SA(1, 1), a1 + hstep, voffA);
            PG8_WAIT_V(8); PG8_WAIT_L(0); PG8_BAR; PG8_MMA(0, 0, At, B0); PG8_MMA(0, 1, At, B1); PG8_BAR; PG8_SCHED;
            PG8_LDA(At, 0, 1); PG8_STAGE(PG8_SB(0, 0), b2, voffB); PG8_STAGE(PG8_SB(0, 1), b2 + hstep, voffB); PG8_STAGE(PG8_SA(0, 0), a2, voffA);
            PG8_WAIT_V(8); PG8_WAIT_L(0); PG8_BAR; PG8_MMA(1, 0, At, B0); PG8_MMA(1, 1, At, B1); PG8_BAR; PG8_SCHED;
            PG8_LDB(B0, 1, 0); PG8_LDB(B1, 1, 1); PG8_SCHED; PG8_LDA(At, 1, 0); PG8_STAGE(PG8_SA(0, 1), a2 + hstep, voffA);
            PG8_WAIT_V(8); PG8_WAIT_L(0); PG8_BAR; PG8_MMA(0, 0, At, B0); PG8_MMA(0, 1, At, B1); PG8_BAR; PG8_SCHED;
            PG8_LDA(At, 1, 1); PG8_STAGE(PG8_SB(1, 0), b3, voffB); PG8_STAGE(PG8_SB(1, 1), b3 + hstep, voffB); PG8_STAGE(PG8_SA(1, 0), a3, voffA);
            PG8_WAIT_V(8); PG8_WAIT_L(0); PG8_BAR; PG8_MMA(1, 0, At, B0); PG8_MMA(1, 1, At, B1); PG8_BAR; PG8_SCHED;
            } else {
            PG8_LDB(B0, 0, 0); PG8_SCHED; PG8_LDA(At, 0, 0); PG8_STAGE(PG8_SA(1, 1), a1 + hstep, voffA);
            PG8_WAIT_L(8); PG8_BAR; PG8_WAIT_L(0); PG8_MMA(0, 0, At, B0); PG8_BAR; PG8_SCHED;
            PG8_LDB(B1, 0, 1); PG8_STAGE(PG8_SB(0, 0), b2, voffB);
            PG8_BAR; PG8_WAIT_L(0); PG8_MMA(0, 1, At, B1); PG8_BAR;
            PG8_LDA(At, 0, 1); PG8_STAGE(PG8_SA(0, 0), a2, voffA);
            PG8_BAR; PG8_WAIT_L(0); PG8_MMA(1, 0, At, B0); PG8_BAR; PG8_SCHED;
            PG8_STAGE(PG8_SB(0, 1), b2 + hstep, voffB);
            PG8_WAIT_V(6); PG8_BAR; PG8_MMA(1, 1, At, B1); PG8_BAR;
            PG8_LDB(B0, 1, 0); PG8_SCHED; PG8_LDA(At, 1, 0); PG8_STAGE(PG8_SA(0, 1), a2 + hstep, voffA);
            PG8_WAIT_L(8); PG8_BAR; PG8_WAIT_L(0); PG8_MMA(0, 0, At, B0); PG8_BAR; PG8_SCHED;
            PG8_LDB(B1, 1, 1); PG8_STAGE(PG8_SB(1, 0), b3, voffB);
            PG8_BAR; PG8_WAIT_L(0); PG8_MMA(0, 1, At, B1); PG8_BAR;
            PG8_LDA(At, 1, 1); PG8_STAGE(PG8_SA(1, 0), a3, voffA);
            PG8_BAR; PG8_WAIT_L(0); PG8_MMA(1, 0, At, B0); PG8_BAR; PG8_SCHED;
            PG8_STAGE(PG8_SB(1, 1), b3 + hstep, voffB);
            PG8_WAIT_V(6); PG8_BAR; PG8_MMA(1, 1, At, B1); PG8_BAR;
            }
        }
        if constexpr (ALIGN_EPI) { if (wr == 0) PG8_BAR; }
        E(acc, cur, wr, wc, fr, fq); S.done(cur);
        if (!has_next) break;
#pragma unroll
        for (int a = 0; a < 2; ++a)
#pragma unroll
            for (int b = 0; b < 2; ++b)
#pragma unroll
                for (int m = 0; m < 4; ++m)
#pragma unroll
                    for (int n = 0; n < 2; ++n) acc[a][b][m][n] = (f32x4){0.f, 0.f, 0.f, 0.f};
        cur = nxt; cA = nA; cB = nB; ++ui;
        if constexpr (ALIGN_EPI) { if (wr == 1) PG8_BAR; }
    }
    PG8_WAIT_V(0);
    if constexpr (!ALIGN_EPI) { if (wr == 0) PG8_BAR; }
    PG8_BAR;
#undef PG8_SA
#undef PG8_SB
#undef PG8_STAGE
#undef PG8_LDA
#undef PG8_LDB
#undef PG8_MMA
#undef PG8_WAIT_V
#undef PG8_WAIT_L
#undef PG8_BAR
#undef PG8_SCHED
}
}
using pg8::Unit;

struct EpiB {
    static constexpr bool PERM = true;
    bf16_t *Q, *F, *I, *ZB, *GB;
    __device__ __forceinline__ void operator()(const f32x4 (&acc)[2][2][4][2], const Unit& u, int wr, int wc, int fr, int fq) const {
        const int seg = u.pn >> 2;
        bf16_t* base = seg == 0 ? Q : seg == 1 ? F : seg == 2 ? I : seg == 3 ? ZB : GB;
        const int col0 = (u.pn & 3) * 256 + wc * 32 + 8 * fq, row0 = u.pm * 256 + wr * 64 + fr;
#pragma unroll
        for (int ai = 0; ai < 2; ++ai)
#pragma unroll
            for (int m = 0; m < 4; ++m) { bf16_t* rowp = base + (size_t)(row0 + ai * 128 + m * 16) * D + col0;
#pragma unroll
                for (int bj = 0; bj < 2; ++bj) { float v[8];
#pragma unroll
                    for (int j = 0; j < 4; ++j) { v[j] = acc[ai][bj][m][0][j]; v[4 + j] = acc[ai][bj][m][1][j]; }
                    u32x4 w;
                    if (seg == 1) { w.x = pk_f16(v[0], v[1]); w.y = pk_f16(v[2], v[3]); w.z = pk_f16(v[4], v[5]); w.w = pk_f16(v[6], v[7]); }
                    else {
                        if (seg != 2) {
#pragma unroll
                            for (int j = 0; j < 8; ++j) { const float s = fsigmoid(v[j]); v[j] = (seg == 4) ? s : v[j] * s; } }
                        w.x = cvt_pk_bf16(v[0], v[1]); w.y = cvt_pk_bf16(v[2], v[3]); w.z = cvt_pk_bf16(v[4], v[5]); w.w = cvt_pk_bf16(v[6], v[7]); }
                    *(u32x4*)(rowp + bj * 128) = w; } }
    }
};
struct EpiA {
    static constexpr bool PERM = true;
    bf16_t *UZ, *V, *GA; float* stats;
    __device__ __forceinline__ void operator()(const f32x4 (&acc)[2][2][4][2], const Unit& u, int wr, int wc, int fr, int fq) const {
        const int row0 = u.pm * 256 + wr * 64 + fr;
        if (u.pn < 8) {
            const int col0 = u.pn * 128 + wc * 32 + 8 * fq;
#pragma unroll
            for (int ai = 0; ai < 2; ++ai)
#pragma unroll
                for (int m = 0; m < 4; ++m) { float v[8];
#pragma unroll
                    for (int j = 0; j < 4; ++j) { v[j] = fgelu(acc[ai][0][m][0][j]) * fsilu(acc[ai][1][m][0][j]); v[4 + j] = fgelu(acc[ai][0][m][1][j]) * fsilu(acc[ai][1][m][1][j]); }
                    u32x4 w; w.x = cvt_pk_bf16(v[0], v[1]); w.y = cvt_pk_bf16(v[2], v[3]); w.z = cvt_pk_bf16(v[4], v[5]); w.w = cvt_pk_bf16(v[6], v[7]);
                    *(u32x4*)(UZ + (size_t)(row0 + ai * 128 + m * 16) * D + col0) = w; }
        } else if (u.pn < 12) {
            const int pnl = u.pn - 8, col0 = pnl * 256 + wc * 32 + 8 * fq;
#pragma unroll
            for (int ai = 0; ai < 2; ++ai)
#pragma unroll
                for (int m = 0; m < 4; ++m) { const int row = row0 + ai * 128 + m * 16; float s = 0.f, ss = 0.f;
#pragma unroll
                    for (int bj = 0; bj < 2; ++bj) { float v[8];
#pragma unroll
                        for (int j = 0; j < 4; ++j) { v[j] = fgelu(acc[ai][bj][m][0][j]); v[4 + j] = fgelu(acc[ai][bj][m][1][j]); }
#pragma unroll
                        for (int j = 0; j < 8; ++j) { s += v[j]; ss += v[j] * v[j]; }
                        u32x4 w; w.x = cvt_pk_bf16(v[0], v[1]); w.y = cvt_pk_bf16(v[2], v[3]); w.z = cvt_pk_bf16(v[4], v[5]); w.w = cvt_pk_bf16(v[6], v[7]);
                        *(u32x4*)(V + (size_t)row * D + col0 + bj * 128) = w; }
                    s = xrow16_sum(s); ss = xrow16_sum(ss);
                    *(f32x2*)(stats + ((size_t)row * 16 + pnl * 4 + wc) * 2) = (f32x2){s, ss}; }
        } else {
            const int col0 = (u.pn - 12) * 256 + wc * 32 + 8 * fq;
#pragma unroll
            for (int ai = 0; ai < 2; ++ai)
#pragma unroll
                for (int m = 0; m < 4; ++m)
#pragma unroll
                    for (int bj = 0; bj < 2; ++bj) { float v[8];
#pragma unroll
                        for (int j = 0; j < 4; ++j) { v[j] = fsigmoid(acc[ai][bj][m][0][j]); v[4 + j] = fsigmoid(acc[ai][bj][m][1][j]); }
                        u32x4 w; w.x = cvt_pk_bf16(v[0], v[1]); w.y = cvt_pk_bf16(v[2], v[3]); w.z = cvt_pk_bf16(v[4], v[5]); w.w = cvt_pk_bf16(v[6], v[7]);
                        *(u32x4*)(GA + (size_t)(row0 + ai * 128 + m * 16) * D + col0 + bj * 128) = w; }
        }
    }
};
template <bool ADD> struct EpiGate {
    static constexpr bool PERM = true;
    const bf16_t* G; const bf16_t* T; bf16_t* O;
    __device__ __forceinline__ void operator()(const f32x4 (&acc)[2][2][4][2], const Unit& u, int wr, int wc, int fr, int fq) const {
        const int col0 = u.pn * 256 + wc * 32 + 8 * fq, row0 = u.pm * 256 + wr * 64 + fr;
#pragma unroll
        for (int ai = 0; ai < 2; ++ai)
#pragma unroll
            for (int m = 0; m < 4; ++m) { const size_t off = (size_t)(row0 + ai * 128 + m * 16) * D + col0;
#pragma unroll
                for (int bj = 0; bj < 2; ++bj) { const u32x4 gq = *(const u32x4*)(G + off + bj * 128);
                    const unsigned gw[4] = {gq.x, gq.y, gq.z, gq.w}; float v[8];
#pragma unroll
                    for (int j = 0; j < 2; ++j) { v[2 * j] = bf_lo(gw[j]) * acc[ai][bj][m][0][2 * j]; v[2 * j + 1] = bf_hi(gw[j]) * acc[ai][bj][m][0][2 * j + 1];
                        v[4 + 2 * j] = bf_lo(gw[2 + j]) * acc[ai][bj][m][1][2 * j]; v[5 + 2 * j] = bf_hi(gw[2 + j]) * acc[ai][bj][m][1][2 * j + 1]; }
                    if (ADD) { const u32x4 tq = *(const u32x4*)(T + off + bj * 128); const unsigned tw[4] = {tq.x, tq.y, tq.z, tq.w};
#pragma unroll
                        for (int j = 0; j < 4; ++j) { v[2 * j] += bf_lo(tw[j]); v[2 * j + 1] += bf_hi(tw[j]); } }
                    u32x4 w; w.x = cvt_pk_bf16(v[0], v[1]); w.y = cvt_pk_bf16(v[2], v[3]); w.z = cvt_pk_bf16(v[4], v[5]); w.w = cvt_pk_bf16(v[6], v[7]);
                    *(u32x4*)(O + off + bj * 128) = w; } }
    }
};
struct EpiO {
    static constexpr bool PERM = false;
    const float *xp, *xs; float* xo; const float* mod;
    __device__ __forceinline__ void operator()(const f32x4 (&acc)[2][2][4][2], const Unit& u, int wr, int wc, int fr, int fq) const {
        const unsigned col0 = (unsigned)(u.pn * 256 + wc * 32 + 4 * fq);
        const float* xt = ((u.pm < MP / 256) ? xp : xs - (size_t)MP * D) + (size_t)u.pm * 256 * D;
        float* ot = xo + (size_t)u.pm * 256 * D;
#pragma unroll
        for (int ai = 0; ai < 2; ++ai) {
            const int ci = cond_of_row(u.pm * 256 + ai * 128 + wr * 64);
            const float* gate = mod + (size_t)ci * 3 * D + 2 * D;
            f32x4 gv[2][2];
#pragma unroll
            for (int bj = 0; bj < 2; ++bj)
#pragma unroll
                for (int n = 0; n < 2; ++n) gv[bj][n] = *(const f32x4*)(gate + (col0 + bj * 128 + n * 16));
#pragma unroll
            for (int m = 0; m < 4; ++m) { const unsigned off = (unsigned)(ai * 128 + wr * 64 + m * 16 + fr) * D + col0;
#pragma unroll
                for (int bj = 0; bj < 2; ++bj)
#pragma unroll
                    for (int n = 0; n < 2; ++n) { const f32x4 xv = *(const f32x4*)(xt + (off + bj * 128 + n * 16));
                        *(f32x4*)(ot + (off + bj * 128 + n * 16)) = xv + gv[bj][n] * acc[ai][bj][m][n]; }
                asm volatile("" ::: "memory"); } }
    }
};


__device__ __forceinline__ int win_src_col(int n) {
    if (n < 4096) return 3072 + n;
    if (n < 5120) return 8192 + (n - 4096);
    n -= 5120;
    if (n < 2048) { const int t = n >> 8, r = n & 255; return r < 128 ? 128 * t + r : 2048 + 128 * t + (r - 128); }
    if (n < 3072) return 1024 + (n - 2048);
    return 7168 + (n - 3072);
}
__device__ __forceinline__ void transpose_item(const float* W, int ldn, int n0s, int k0, bf16_t* WT, int n0d, LAS float* scr, int lane) {
#pragma unroll 8
    for (int i = 0; i < 32; ++i) { const int kk = 2 * i + (lane >> 5); scr[kk * 33 + (lane & 31)] = W[(size_t)(k0 + kk) * ldn + n0s + (lane & 31)]; }
    __builtin_amdgcn_s_waitcnt(0xc07f); asm volatile("" ::: "memory");
    const int c = lane & 7;
#pragma unroll
    for (int j = 0; j < 4; ++j) { const int n = (lane >> 3) + 8 * j; const LAS float* s = scr + (8 * c) * 33 + n;
        u32x4 o; o.x = cvt_pk_bf16(s[0 * 33], s[1 * 33]); o.y = cvt_pk_bf16(s[2 * 33], s[3 * 33]); o.z = cvt_pk_bf16(s[4 * 33], s[5 * 33]); o.w = cvt_pk_bf16(s[6 * 33], s[7 * 33]);
        *(u32x4*)(WT + (size_t)(n0d + n) * D + k0 + 8 * c) = o; }
    __builtin_amdgcn_s_waitcnt(0xc07f); asm volatile("" ::: "memory");
}
__device__ __forceinline__ void phase_prep(CParams* p, LAS unsigned char* lds) {
    const int tid = otid(), lane = tid & 63, wave = tid >> 6, G = ogrid(), bid = obid();
    {
        LAS float* sc = (LAS float*)lds;
        LAS float* part = sc + 8192;
        for (int it = bid; it < 576; it += G) {
            const int l = it / 288, rg = (it % 288) / 48, cb = it % 48;
            __syncthreads();
            for (int e = tid; e < 8 * 1024; e += 512) { const int r = e >> 10, k = e & 1023, ci = rg * 8 + r;
                const float cv = ci < 16 ? p->c_prompt[(size_t)ci * D + k] : p->c_sample[(size_t)(ci - 16) * D + k]; sc[k * 8 + r] = fsilu(cv); }
            __syncthreads();
            const int col = cb * 64 + lane; const float* w = p->w_ada + (size_t)l * D * 3 * D + (size_t)(wave * 128) * 3 * D + col;
            float a[8] = {0.f, 0.f, 0.f, 0.f, 0.f, 0.f, 0.f, 0.f};
            for (int k8 = 0; k8 < 128; k8 += 8) { float wv[8];
#pragma unroll
                for (int u = 0; u < 8; ++u) wv[u] = w[(size_t)(k8 + u) * 3 * D];
#pragma unroll
                for (int u = 0; u < 8; ++u) { const LAS float* s = sc + (wave * 128 + k8 + u) * 8; const f32x4 s0 = *(const LAS f32x4*)s, s1 = *(const LAS f32x4*)(s + 4);
                    a[0] += s0.x * wv[u]; a[1] += s0.y * wv[u]; a[2] += s0.z * wv[u]; a[3] += s0.w * wv[u]; a[4] += s1.x * wv[u]; a[5] += s1.y * wv[u]; a[6] += s1.z * wv[u]; a[7] += s1.w * wv[u]; } }
#pragma unroll
            for (int r = 0; r < 8; ++r) part[(wave * 8 + r) * 64 + lane] = a[r];
            __syncthreads();
            { float s = 0.f;
#pragma unroll
              for (int w2 = 0; w2 < 8; ++w2) s += part[(w2 * 8 + wave) * 64 + lane];
              ((float*)(p->ws + WS_MOD))[((size_t)l * NCOND + rg * 8 + wave) * 3 * D + col] = s + p->b_ada[(size_t)l * 3 * D + col]; }
        }
        __syncthreads();
    }
    {
        LAS float* scr = (LAS float*)(lds + wave * 8704);
        const int gw = bid * 8 + wave, NGW = G * 8;
        constexpr int I_IN = 16 * (NIN / 32), I_SQ = 16 * (D / 32), PER_L = I_IN + 3 * I_SQ;
        for (int it = gw; it < 2 * PER_L; it += NGW) { const int l = it / PER_L; int r = it % PER_L;
            if (r < I_IN) { const int kb = r / (NIN / 32), nb = r % (NIN / 32);
                transpose_item(p->w_in + (size_t)l * D * NIN, NIN, win_src_col(nb * 32), kb * 64, (bf16_t*)(p->ws + WS_WIN) + (size_t)l * NIN * D, nb * 32, scr, lane); continue; }
            r -= I_IN; const int which = r / I_SQ; r %= I_SQ; const int kb = r / (D / 32), nb = r % (D / 32);
            const float* src = (which == 0 ? p->w_pa : which == 1 ? p->w_pb : p->w_o) + (size_t)l * D * D;
            bf16_t* dst = (bf16_t*)(p->ws + (which == 0 ? WS_WPA : which == 1 ? WS_WPB : WS_WO)) + (size_t)l * D * D;
            transpose_item(src, D, nb * 32, kb * 64, dst, nb * 32, scr, lane); }
    }
}

__device__ __forceinline__ void phase_norm(CParams* p, int l, const float* xp, const float* xs, bf16_t* H) {
    const int tid = otid(), lane = tid & 63, gw = obid() * 8 + (tid >> 6), NGW = ogrid() * 8;
    const float* g = p->norm_g + (size_t)l * D; const float* mod = (const float*)(p->ws + WS_MOD) + (size_t)l * NCOND * 3 * D;
    for (int row = gw; row < M; row += NGW) {
        const float* xr = row < MP ? xp + (size_t)row * D : xs + (size_t)(row - MP) * D;
        const float* mrow = mod + (size_t)cond_of_row(row) * 3 * D;
        f32x4 v[4]; float s = 0.f;
#pragma unroll
        for (int j = 0; j < 4; ++j) { v[j] = *(const f32x4*)(xr + 4 * lane + 256 * j); s += (v[j].x * v[j].x + v[j].y * v[j].y) + (v[j].z * v[j].z + v[j].w * v[j].w); }
        const float r = rsqrtf(wave_sum(s) * (1.f / D) + EPS);
#pragma unroll
        for (int j = 0; j < 4; ++j) { const int c = 4 * lane + 256 * j; const f32x4 gv = *(const f32x4*)(g + c), sh = *(const f32x4*)(mrow + c), sc = *(const f32x4*)(mrow + D + c);
            const f32x4 h = (v[j] * r) * gv * (sc + 1.0f) + sh;
            u32x2 w; w.x = cvt_pk_bf16(h.x, h.y); w.y = cvt_pk_bf16(h.z, h.w); *(u32x2*)(H + (size_t)row * D + c) = w; }
    }
}
__device__ __forceinline__ void phase_final(CParams* p) {
    const int tid = otid(), lane = tid & 63, gw = obid() * 8 + (tid >> 6), NGW = ogrid() * 8;
    for (int row = gw; row < M; row += NGW) {
        float* xr = p->out + OUT_Y + (size_t)row * D;
        f32x4 v[4]; float s = 0.f;
#pragma unroll
        for (int j = 0; j < 4; ++j) { v[j] = *(const f32x4*)(xr + 4 * lane + 256 * j); s += (v[j].x * v[j].x + v[j].y * v[j].y) + (v[j].z * v[j].z + v[j].w * v[j].w); }
        const float r = rsqrtf(wave_sum(s) * (1.f / D) + EPS);
#pragma unroll
        for (int j = 0; j < 4; ++j) { const int c = 4 * lane + 256 * j; const f32x4 gv = *(const f32x4*)(p->final_g + c); *(f32x4*)(xr + c) = (v[j] * r) * gv; }
    }
}

__device__ __forceinline__ void phase_scan(CParams* p, int l, const bf16_t* Q, const bf16_t* F, bf16_t* I, float* SQ, LAS unsigned char* lds) {
    const int tid = otid(), G = ogrid(), bid = obid();
    LAS float* fS = (LAS float*)lds; LAS float* kS = fS + 2048; LAS float* qS = kS + 2048; LAS float* iS = qS + 2048; LAS float* op = iS + 2048;
    const int lane = tid & 63, kg = lane & 15, vg = (tid >> 6) * 4 + (lane >> 4), k0 = kg * 8;
    const int st = tid >> 5, sc4 = (tid & 31) * 4, vl2 = (tid & 31) * 2;
    for (int it = bid; it < 768; it += G) {
        const bool prompt = it < 256; const int id = prompt ? it : it - 256, b = id >> 4, h = (id >> 1) & 7, vh = id & 1;
        const int T = prompt ? 2048 : 64, row0 = prompt ? b * 2048 : MP + b * 64, v0 = vh * 64 + vg * 2;
        float* sout = p->out + (prompt ? OUT_SP + ((size_t)(l * 16 + b) * 8 + h) * 16384 : OUT_SS + ((size_t)(l * 32 + b) * 8 + h) * 16384);
        f32x2 S[8];
        if (prompt) {
#pragma unroll
            for (int j = 0; j < 8; ++j) S[j] = (f32x2){0.f, 0.f};
        } else { const float* sin = p->state_hgrn + ((size_t)(l * 32 + b) * 8 + h) * 16384;
#pragma unroll
            for (int j = 0; j < 8; ++j) S[j] = *(const f32x2*)(sin + (k0 + j) * 128 + v0); }
        float lb[4];
#pragma unroll
        for (int j = 0; j < 4; ++j) { const int hk = h * 128 + sc4 + j; lb[j] = l == 0 ? 0.f : fsigmoid(p->lb_raw[D + hk] - p->lb_raw[hk]); }
        const size_t off0 = (size_t)(row0 + st) * D + h * 128 + sc4;
        u32x2 qw = *(const u32x2*)(Q + off0), fw = *(const u32x2*)(F + off0), iw = *(const u32x2*)(I + off0);
        auto stage = [&](int tnext) {
            *(LAS f32x4*)(qS + st * 128 + sc4) = (f32x4){bf_lo(qw.x), bf_hi(qw.x), bf_lo(qw.y), bf_hi(qw.y)};
            *(LAS f32x4*)(iS + st * 128 + sc4) = (f32x4){bf_lo(iw.x), bf_hi(iw.x), bf_lo(iw.y), bf_hi(iw.y)};
            const float z[4] = {f16_lo(fw.x), f16_hi(fw.x), f16_lo(fw.y), f16_hi(fw.y)}; f32x4 fv, kv;
#pragma unroll
            for (int j = 0; j < 4; ++j) { const float sg = fsigmoid(z[j]); fv[j] = lb[j] + (1.f - lb[j]) * sg; kv[j] = (1.f - lb[j]) * (1.f - sg); }
            *(LAS f32x4*)(fS + st * 128 + sc4) = fv; *(LAS f32x4*)(kS + st * 128 + sc4) = kv;
            if (tnext < T) { const size_t off = off0 + (size_t)tnext * D; qw = *(const u32x2*)(Q + off); fw = *(const u32x2*)(F + off); iw = *(const u32x2*)(I + off); }
        };
        __syncthreads();
        stage(16);
        for (int t0 = 0; t0 < T; t0 += 16) {
            __syncthreads();
            {
                f32x2 iv = *(const LAS f32x2*)(iS + v0);
                f32x4 fa = *(const LAS f32x4*)(fS + k0), fb = *(const LAS f32x4*)(fS + k0 + 4);
                f32x4 ka = *(const LAS f32x4*)(kS + k0), kb = *(const LAS f32x4*)(kS + k0 + 4);
                f32x4 qa = *(const LAS f32x4*)(qS + k0), qb = *(const LAS f32x4*)(qS + k0 + 4);
#pragma unroll
                for (int t = 0; t < 16; ++t) {
                    const int tn = (t + 1 < 16) ? t + 1 : t;
                    const f32x2 ivn = *(const LAS f32x2*)(iS + tn * 128 + v0);
                    const f32x4 fan = *(const LAS f32x4*)(fS + tn * 128 + k0), fbn = *(const LAS f32x4*)(fS + tn * 128 + k0 + 4);
                    const f32x4 kan = *(const LAS f32x4*)(kS + tn * 128 + k0), kbn = *(const LAS f32x4*)(kS + tn * 128 + k0 + 4);
                    const f32x4 qan = *(const LAS f32x4*)(qS + tn * 128 + k0), qbn = *(const LAS f32x4*)(qS + tn * 128 + k0 + 4);
                    f32x2 o = (f32x2){0.f, 0.f};
#pragma unroll
                    for (int j = 0; j < 4; ++j) { S[j] = S[j] * fa[j] + iv * ka[j]; o += S[j] * qa[j]; S[4 + j] = S[4 + j] * fb[j] + iv * kb[j]; o += S[4 + j] * qb[j]; }
                    o.x = row16_sum(o.x); o.y = row16_sum(o.y);
                    if (kg == 0) *(LAS f32x2*)(op + t * 64 + vg * 2) = o;
                    iv = ivn; fa = fan; fb = fbn; ka = kan; kb = kbn; qa = qan; qb = qbn;
                }
            }
            __syncthreads();
            { const f32x2 o = *(const LAS f32x2*)(op + st * 64 + vl2); float ss = o.x * o.x + o.y * o.y;
#pragma unroll
              for (int w = 1; w < 32; w <<= 1) ss += __shfl_xor(ss, w);
              const int row = row0 + t0 + st;
              if ((tid & 31) == 0) SQ[((size_t)row * 8 + h) * 2 + vh] = ss;
              *(unsigned*)(I + (size_t)row * D + h * 128 + vh * 64 + vl2) = cvt_pk_bf16(o.x, o.y); }
            if (t0 + 16 < T) stage(t0 + 32);
        }
#pragma unroll
        for (int j = 0; j < 8; ++j) *(f32x2*)(sout + (k0 + j) * 128 + v0) = S[j];
    }
}
__device__ __forceinline__ void phase_hnorm(CParams* p, int l, const bf16_t* O, bf16_t* Q, const bf16_t* ZB, const float* SQ) {
    const int tid = otid(), G = ogrid(), bid = obid();
    const float* gnp = p->gnorm_g + (size_t)l * D;
    for (int idx = bid * 512 + tid; idx < M * 128; idx += G * 512) {
        const int row = idx >> 7, c8 = (idx & 127) * 8, h = c8 >> 7;
        const f32x2 sq = *(const f32x2*)(SQ + ((size_t)row * 8 + h) * 2);
        const float r = rsqrtf((sq.x + sq.y) * (1.f / 128.f) + EPS);
        const u32x4 ow = *(const u32x4*)(O + (size_t)row * D + c8), zw = *(const u32x4*)(ZB + (size_t)row * D + c8);
        const f32x4 g0 = *(const f32x4*)(gnp + c8), g1 = *(const f32x4*)(gnp + c8 + 4);
        const unsigned oa[4] = {ow.x, ow.y, ow.z, ow.w}, za[4] = {zw.x, zw.y, zw.z, zw.w}; const float ga[8] = {g0.x, g0.y, g0.z, g0.w, g1.x, g1.y, g1.z, g1.w};
        u32x4 w; unsigned wa[4];
#pragma unroll
        for (int j = 0; j < 4; ++j) wa[j] = cvt_pk_bf16((bf_lo(oa[j]) * r) * ga[2 * j] * bf_lo(za[j]), (bf_hi(oa[j]) * r) * ga[2 * j + 1] * bf_hi(za[j]));
        w.x = wa[0]; w.y = wa[1]; w.z = wa[2]; w.w = wa[3];
        *(u32x4*)(Q + (size_t)row * D + c8) = w;
    }
}

__device__ __forceinline__ void phase_gmlp(CParams* p, int l, bf16_t* UZ, const bf16_t* V, LAS unsigned char* lds) {
    const int tid = otid(), G = ogrid(), bid = obid();
    constexpr int STR = 272;
    LAS unsigned char* vnT = lds;
    LAS unsigned char* Wb = lds + 256 * STR;
    LAS float* rs = (LAS float*)(lds + 384 * STR);
    const float* stats = (const float*)(p->ws + WS_STATS);
    const int lane = tid & 63, wave = tid >> 6, fr = lane & 15, fq = lane >> 4;
    int g_staged = -1;
    for (int it = bid; it < 288 * 4; it += G) {
        const int cix = it >> 2, g = it & 3, cb = g * 256;
        const bool prompt = cix < 256; const int R = prompt ? 128 : 64, row0 = prompt ? cix * 128 : MP + (cix - 256) * 64;
        __syncthreads();
        u32x4 vq[8];
#pragma unroll
        for (int i = 0; i < 8; ++i) { const int u = tid + 512 * i;
            if (u < R * 32) { const int s = prompt ? (u & 127) : (u & 63), c8 = (prompt ? (u >> 7) : (u >> 6)) * 8; vq[i] = *(const u32x4*)(V + (size_t)(row0 + s) * D + cb + c8); } }
        if (tid < R) { const float* sp = stats + (size_t)(row0 + tid) * 32; float s = 0.f, ss = 0.f;
#pragma unroll
            for (int j = 0; j < 16; ++j) { const f32x2 a2 = *(const f32x2*)(sp + 2 * j); s += a2.x; ss += a2.y; }
            const float mu = s * (1.f / D), var = fmaxf(ss * (1.f / D) - mu * mu, 0.f); rs[2 * tid] = mu; rs[2 * tid + 1] = rsqrtf(var + EPS); }
        if (g != g_staged) { g_staged = g; const float* wsrc = p->w_s + (size_t)(l * 4 + g) * 16384;
#pragma unroll
          for (int i = 0; i < 8; ++i) { const int u = tid + 512 * i, t = u >> 5, s4 = (u & 31) * 4; f32x4 w4 = *(const f32x4*)(wsrc + t * 128 + s4);
              w4.x = (s4 + 0 <= t) ? w4.x : 0.f; w4.y = (s4 + 1 <= t) ? w4.y : 0.f; w4.z = (s4 + 2 <= t) ? w4.z : 0.f; w4.w = (s4 + 3 <= t) ? w4.w : 0.f;
              u32x2 q; q.x = cvt_pk_bf16(w4.x, w4.y); q.y = cvt_pk_bf16(w4.z, w4.w); *(LAS u32x2*)(Wb + t * STR + s4 * 2) = q; } }
        __syncthreads();
#pragma unroll
        for (int i = 0; i < 8; ++i) { const int u = tid + 512 * i;
            if (u < R * 32) { const int s = prompt ? (u & 127) : (u & 63), c8 = (prompt ? (u >> 7) : (u >> 6)) * 8;
            const u32x4 q = vq[i]; const float mu = rs[2 * s], rstd = rs[2 * s + 1];
            const float* lg = p->ln_v_g + (size_t)l * D + cb + c8; const float* lbp = p->ln_v_b + (size_t)l * D + cb + c8;
            const f32x4 g0 = *(const f32x4*)lg, g1 = *(const f32x4*)(lg + 4), b0 = *(const f32x4*)lbp, b1 = *(const f32x4*)(lbp + 4);
            f32x4 x0 = (f32x4){bf_lo(q.x), bf_hi(q.x), bf_lo(q.y), bf_hi(q.y)}, x1 = (f32x4){bf_lo(q.z), bf_hi(q.z), bf_lo(q.w), bf_hi(q.w)};
            x0 = (x0 - mu) * rstd * g0 + b0; x1 = (x1 - mu) * rstd * g1 + b1;
            const unsigned pa = cvt_pk_bf16(x0.x, x0.y), pb = cvt_pk_bf16(x0.z, x0.w), pc = cvt_pk_bf16(x1.x, x1.y), pd = cvt_pk_bf16(x1.z, x1.w);
            LAS unsigned short* dst = (LAS unsigned short*)(vnT + c8 * STR + s * 2);
            dst[0] = (unsigned short)(pa & 0xffffu); dst[STR / 2] = (unsigned short)(pa >> 16); dst[2 * (STR / 2)] = (unsigned short)(pb & 0xffffu); dst[3 * (STR / 2)] = (unsigned short)(pb >> 16);
            dst[4 * (STR / 2)] = (unsigned short)(pc & 0xffffu); dst[5 * (STR / 2)] = (unsigned short)(pc >> 16); dst[6 * (STR / 2)] = (unsigned short)(pd & 0xffffu); dst[7 * (STR / 2)] = (unsigned short)(pd >> 16);
            if (!prompt) { float* vo = p->out + OUT_VS + ((size_t)(l * 32 + (cix - 256)) * 64 + s) * D + cb + c8; *(f32x4*)vo = x0; *(f32x4*)(vo + 4) = x1; } } }
        const int t0 = wave * 16, t = t0 + fr;
        bf16_t* urow = UZ + (size_t)(row0 + t) * D + cb + 4 * fq;
        u32x2 uzr[16]; float bias = 0.f;
        if (t0 < R) { bias = p->b_s[(size_t)(l * 4 + g) * 128 + t];
#pragma unroll
            for (int c = 0; c < 16; ++c) uzr[c] = *(const u32x2*)(urow + c * 16); }
        __syncthreads();
        if (t0 < R) {
            f32x4 acc[16];
#pragma unroll
            for (int c = 0; c < 16; ++c) acc[c] = (f32x4){0.f, 0.f, 0.f, 0.f};
            const int nsteps = (t0 + 15) / 32 + 1;
            for (int ks = 0; ks < nsteps; ++ks) { const int soff = (32 * ks + 8 * fq) * 2;
                const bf16x8 Bf = *(const LAS bf16x8*)(Wb + (t0 + fr) * STR + soff);
#pragma unroll
                for (int c = 0; c < 16; ++c) { const bf16x8 Af = *(const LAS bf16x8*)(vnT + (c * 16 + fr) * STR + soff); acc[c] = __builtin_amdgcn_mfma_f32_16x16x32_bf16(Af, Bf, acc[c], 0, 0, 0); } }
#pragma unroll
            for (int c = 0; c < 16; ++c) { const u32x2 uz = uzr[c];
                u32x2 w; w.x = cvt_pk_bf16(bf_lo(uz.x) * (acc[c].x + bias), bf_hi(uz.x) * (acc[c].y + bias)); w.y = cvt_pk_bf16(bf_lo(uz.y) * (acc[c].z + bias), bf_hi(uz.y) * (acc[c].w + bias));
                *(u32x2*)(urow + c * 16) = w; }
        }
    }
}

__device__ __forceinline__ void grid_barrier(unsigned* ctr, unsigned target) {
    asm volatile("s_waitcnt vmcnt(0)" ::: "memory");
    __syncthreads();
    if (threadIdx.x == 0) {
        __builtin_amdgcn_fence(__ATOMIC_RELEASE, "agent");
        asm volatile("s_waitcnt vmcnt(0)" ::: "memory");
        (void)__hip_atomic_fetch_add(ctr, 1u, __ATOMIC_RELAXED, __HIP_MEMORY_SCOPE_AGENT);
        unsigned sp = 0u;
        while (__hip_atomic_load(ctr, __ATOMIC_RELAXED, __HIP_MEMORY_SCOPE_AGENT) < target) { __builtin_amdgcn_s_sleep(1); if (++sp > (1u << 22)) break; }
        __builtin_amdgcn_fence(__ATOMIC_ACQUIRE, "agent");
        asm volatile("s_waitcnt vmcnt(0)" ::: "memory");
    }
    __syncthreads();
}

__global__ void __launch_bounds__(512) fwd_kernel(Params p_arg) {
    extern __shared__ __attribute__((aligned(16))) unsigned char shm[];
    LAS unsigned char* lds = (LAS unsigned char*)shm;
    const int ph_lo = p_arg.ph_lo, ph_hi = p_arg.ph_hi;
    for (int ph = ph_lo; ph < ph_hi; ++ph) {
        CParams* p = (CParams*)__builtin_amdgcn_kernarg_segment_ptr(); asm volatile("" : "+s"(p));
        unsigned char* ws = p->ws;
        bf16_t* B0 = (bf16_t*)(ws + WS_BUF); bf16_t* B1 = B0 + (size_t)M * D; bf16_t* B2 = B1 + (size_t)M * D; bf16_t* B3 = B2 + (size_t)M * D; bf16_t* B4 = B3 + (size_t)M * D; bf16_t* B5 = B4 + (size_t)M * D;
        float* xbuf = p->out + OUT_Y;
        const int G = ogrid(), bid = obid();
        if (ph == 0) { if (bid == 0 && threadIdx.x == 0) __hip_atomic_store((unsigned*)(ws + WS_BAR), 0u, __ATOMIC_RELAXED, __HIP_MEMORY_SCOPE_AGENT); phase_prep(p, lds); }
        else if (ph == 19) phase_final(p);
        else {
            const int l = (ph - 1) / 9, sub = (ph - 1) % 9;
            const float* xp = l == 0 ? p->x_prompt : xbuf; const float* xs = l == 0 ? p->x_sample : xbuf + (size_t)MP * D;
            const bf16_t* WinT = (const bf16_t*)(ws + WS_WIN) + (size_t)l * NIN * D;
            pg8::StaticOrder S;
            if (sub == 0) phase_norm(p, l, xp, xs, B0);
            else if (sub == 1) { pg8::Gemm g{B0, WinT, M, NB_COLS, D}; S.init(M, NB_COLS, G, bid); EpiB E{B1, B2, B3, B5, B4};
                pg8::gemm_phase<EpiB, pg8::StaticOrder, true, true>(lds, g, S, E); }
            else if (sub == 2) phase_scan(p, l, B1, B2, B3, (float*)(ws + WS_STATS), lds);
            else if (sub == 3) phase_hnorm(p, l, B3, B1, B5, (const float*)(ws + WS_STATS));
            else if (sub == 4) { pg8::Gemm g{B1, (const bf16_t*)(ws + WS_WPB) + (size_t)l * D * D, M, D, D}; S.init(M, D, G, bid); EpiGate<false> E{B4, nullptr, B2};
                pg8::gemm_phase<EpiGate<false>, pg8::StaticOrder, true, true>(lds, g, S, E); }
            else if (sub == 5) { pg8::Gemm g{B0, WinT + (size_t)NB_COLS * D, M, NA_COLS, D}; S.init(M, NA_COLS, G, bid); EpiA E{B3, B5, B4, (float*)(ws + WS_STATS)};
                pg8::gemm_phase<EpiA, pg8::StaticOrder, true, true>(lds, g, S, E); }
            else if (sub == 6) phase_gmlp(p, l, B3, B5, lds);
            else if (sub == 7) { pg8::Gemm g{B3, (const bf16_t*)(ws + WS_WPA) + (size_t)l * D * D, M, D, D}; S.init(M, D, G, bid); EpiGate<true> E{B4, B2, B5};
                pg8::gemm_phase<EpiGate<true>, pg8::StaticOrder, true, true>(lds, g, S, E); }
            else { pg8::Gemm g{B5, (const bf16_t*)(ws + WS_WO) + (size_t)l * D * D, M, D, D}; S.init(M, D, G, bid);
                EpiO E{xp, xs, xbuf, (const float*)(ws + WS_MOD) + (size_t)l * NCOND * 3 * D};
                pg8::gemm_phase<EpiO, pg8::StaticOrder, true, true>(lds, g, S, E); }
        }
#if MK_ONE_LAUNCH
        if (ph + 1 < ph_hi) { if (ph == 0) cg::this_grid().sync(); else grid_barrier((unsigned*)(ws + WS_BAR), (unsigned)ph * (unsigned)G); }
#endif
    }
}


extern "C" void kernel_launch(void* const* d_in, const int* in_sizes, int n_in, void* d_out, int out_size, void* d_ws, size_t ws_size, hipStream_t stream) {
    static int grid = 0;
    if (grid == 0) {
        if (n_in != 19 || ws_size < WS_END) { fprintf(stderr, "kernel_launch: need 19 inputs and %zu bytes of workspace; got %d, %zu\n", (size_t)WS_END, n_in, ws_size); grid = -1; return; }
        if (hipFuncSetAttribute((const void*)fwd_kernel, hipFuncAttributeMaxDynamicSharedMemorySize, LDS_BYTES) != hipSuccess) { fprintf(stderr, "kernel_launch: hipFuncSetAttribute failed\n"); grid = -1; return; }
        int dev = 0, cus = 0, per_cu = 0;
        hipGetDevice(&dev); hipDeviceGetAttribute(&cus, hipDeviceAttributeMultiprocessorCount, dev);
        hipOccupancyMaxActiveBlocksPerMultiprocessor(&per_cu, (const void*)fwd_kernel, 512, LDS_BYTES);
        if (per_cu < 1) { fprintf(stderr, "kernel_launch: occupancy query says %d blocks per CU\n", per_cu); per_cu = 1; }
        (void)hipGetLastError();
        grid = cus;
    }
    if (grid < 0) return;
    Params p{};
    const float** pp = (const float**)&p;
    for (int i = 0; i < 19; ++i) pp[i] = (const float*)d_in[i];
    p.out = (float*)d_out; p.ws = (unsigned char*)d_ws;
#if MK_ONE_LAUNCH
    p.ph_lo = 0; p.ph_hi = 20;
    void* args[] = {&p};
    hipError_t e = hipLaunchCooperativeKernel((const void*)fwd_kernel, dim3(grid), dim3(512), args, LDS_BYTES, stream);
    if (e != hipSuccess) fprintf(stderr, "cooperative launch failed: %s (grid %d)\n", hipGetErrorString(e), grid);
#else
    for (int ph = 0; ph < 20; ++ph) { p.ph_lo = ph; p.ph_hi = ph + 1; hipLaunchKernelGGL(fwd_kernel, dim3(grid), dim3(512), LDS_BYTES, stream, p); }
#endif
}
```

```cpp
#include <hip/hip_runtime.h>
#include <hip/hip_cooperative_groups.h>
#include <cstdio>
#include <cstdint>
namespace cg = cooperative_groups;

#ifndef MK_ONE_LAUNCH
#define MK_ONE_LAUNCH 1
#endif

#define LAS __attribute__((address_space(3)))
typedef unsigned short bf16_t;
typedef short bf16x8 __attribute__((ext_vector_type(8)));
typedef float f32x4 __attribute__((ext_vector_type(4)));
typedef float f32x2 __attribute__((ext_vector_type(2)));
typedef unsigned u32x4 __attribute__((ext_vector_type(4)));
typedef unsigned u32x2 __attribute__((ext_vector_type(2)));
typedef _Float16 f16x2 __attribute__((ext_vector_type(2)));

constexpr int D = 1024, MP = 32768, MS = 2048, M = MP + MS, NCOND = 48, NIN = 9216;
constexpr int NB_COLS = 5120, NA_COLS = 4096;
constexpr float EPS = 1e-6f;
constexpr size_t OUT_Y = 0, OUT_SP = (size_t)M * D, OUT_SS = OUT_SP + (size_t)2 * 16 * 8 * 16384, OUT_VS = OUT_SS + (size_t)2 * 32 * 8 * 16384;
constexpr size_t BUF_BYTES = (size_t)M * D * 2;
constexpr size_t WS_WIN = 0;
constexpr size_t WS_WPA = WS_WIN + (size_t)2 * NIN * D * 2;
constexpr size_t WS_WPB = WS_WPA + (size_t)2 * D * D * 2;
constexpr size_t WS_WO = WS_WPB + (size_t)2 * D * D * 2;
constexpr size_t WS_MOD = WS_WO + (size_t)2 * D * D * 2;
constexpr size_t WS_WTP = WS_MOD + (size_t)2 * NCOND * 3 * D * 4;
constexpr size_t WS_STATS = WS_WTP + (size_t)2 * 4 * 16384 * 4;
constexpr size_t WS_BUF = (WS_STATS + (size_t)M * 16 * 2 * 4 + 4095) & ~(size_t)4095;
constexpr size_t WS_BAR = WS_BUF + 6 * BUF_BYTES;
constexpr size_t WS_END = WS_BAR + 256;
constexpr int LDS_BYTES = 131072 + 4096;

struct Params {
    const float *x_prompt, *x_sample, *state_hgrn, *c_prompt, *c_sample, *w_ada, *b_ada, *norm_g, *w_in, *ln_v_g, *ln_v_b, *w_s, *b_s, *lb_raw, *gnorm_g, *w_pa, *w_pb, *w_o, *final_g;
    float* out; unsigned char* ws;
    int ph_lo, ph_hi;
};

typedef const Params __attribute__((address_space(4))) CParams;
typedef __bf16 bf16x2_t __attribute__((ext_vector_type(2)));
__device__ __forceinline__ unsigned cvt_pk_bf16(float lo, float hi) { const f32x2 v = {lo, hi}; const bf16x2_t h = __builtin_convertvector(v, bf16x2_t); return __builtin_bit_cast(unsigned, h); }
__device__ __forceinline__ float bf_lo(unsigned u) { return __uint_as_float(u << 16); }
__device__ __forceinline__ float bf_hi(unsigned u) { return __uint_as_float(u & 0xffff0000u); }
__device__ __forceinline__ unsigned pk_f16(float a, float b) { f16x2 h; h.x = (_Float16)a; h.y = (_Float16)b; return __builtin_bit_cast(unsigned, h); }
__device__ __forceinline__ float f16_lo(unsigned u) { f16x2 h = __builtin_bit_cast(f16x2, u); return (float)h.x; }
__device__ __forceinline__ float f16_hi(unsigned u) { f16x2 h = __builtin_bit_cast(f16x2, u); return (float)h.y; }
__device__ __forceinline__ float fsigmoid(float x) { return __builtin_amdgcn_rcpf(1.0f + __expf(-x)); }
__device__ __forceinline__ float fsilu(float x) { return x * fsigmoid(x); }
__device__ __forceinline__ float fgelu(float x) { return x * fsigmoid(1.5957691216057308f * (x + 0.044715f * x * x * x)); }
__device__ __forceinline__ float wave_sum(float v) {
#pragma unroll
    for (int o = 1; o < 64; o <<= 1) v += __shfl_xor(v, o);
    return v;
}
__device__ __forceinline__ int otid() { int t = threadIdx.x; asm volatile("" : "+v"(t)); return t; }
__device__ __forceinline__ int obid() { int b = blockIdx.x; asm volatile("" : "+s"(b)); return b; }
__device__ __forceinline__ int ogrid() { int g = gridDim.x; asm volatile("" : "+s"(g)); return g; }
__device__ __forceinline__ float xrow16_sum(float x) {
    auto s = __builtin_amdgcn_permlane16_swap(__float_as_uint(x), __float_as_uint(x), false, false);
    x = __uint_as_float(s[0]) + __uint_as_float(s[1]);
    auto t = __builtin_amdgcn_permlane32_swap(__float_as_uint(x), __float_as_uint(x), false, false);
    return __uint_as_float(t[0]) + __uint_as_float(t[1]);
}
template <int CTRL> __device__ __forceinline__ float dpp_mov(float x) { return __builtin_bit_cast(float, __builtin_amdgcn_mov_dpp(__builtin_bit_cast(int, x), CTRL, 0xf, 0xf, true)); }
__device__ __forceinline__ float row16_sum(float x) {
    x += dpp_mov<0xB1>(x); x += dpp_mov<0x4E>(x); x += dpp_mov<0x124>(x); x += dpp_mov<0x128>(x); return x;
}
__device__ __forceinline__ int cond_of_row(int r) { return r < MP ? (r >> 11) : 16 + ((r - MP) >> 6); }

namespace pg8 {
constexpr int BM = 256, BK = 64, HALF = 128, HTB = HALF * BK * 2, STAGE_BYTES = 8 * HTB, NXCD = 8, WGM = 8;
__host__ __device__ __forceinline__ int lds_byte(int r, int c) { const int st = (r >> 4) * 2 + (c >> 5), rr = r & 15, cc = c & 31, ob = rr * 64 + cc * 2; return st * 1024 + (ob ^ (((ob >> 9) & 1) << 5)); }
__host__ __device__ __forceinline__ void stage_rc(int b, int& R, int& C) { const int st = b / 1024, sb = b % 1024, swz = sb ^ (((sb >> 9) & 1) << 5); R = (st >> 1) * 16 + swz / 64; C = (st & 1) * 32 + (swz % 64) / 2; }
__host__ __device__ __forceinline__ int perm32(int rho) { const int n = rho >> 4, i = rho & 15; return 8 * (i >> 2) + 4 * n + (i & 3); }
struct Unit { int pm, pn; };
struct Gemm { const bf16_t* A; const bf16_t* Bt; int M, N, K; };
struct StaticOrder {
    int nM, nN, nwg, G, c;
    __host__ __device__ void init(int M_, int N_, int G_, int c_) { nM = M_ / BM; nN = N_ / BM; nwg = nM * nN; G = G_; c = c_; }
    __host__ __device__ bool next(int i, Unit& u) const {
        const long L = (long)i * G + c; if (L >= nwg) return false;
        int wgid = (int)L; { const int q = nwg / NXCD, r = nwg % NXCD, xcd = wgid % NXCD, off = wgid / NXCD; wgid = (xcd < r ? xcd * (q + 1) : r * (q + 1) + (xcd - r) * q) + off; }
        const int nig = WGM * nN, gid = wgid / nig, fm = gid * WGM, gsz = (nM - fm) < WGM ? (nM - fm) : WGM;
        u.pm = fm + ((wgid % nig) % gsz); u.pn = (wgid % nig) / gsz; return true;
    }
    __device__ __forceinline__ void a_ready(const Unit&) const {}
    __device__ __forceinline__ void done(const Unit&) const {}
};

template <class Epi, class Sched, bool ALIGN_EPI = false, bool SP2 = false>
__device__ __forceinline__ void gemm_phase(LAS unsigned char* lds, const Gemm g, const Sched& S, const Epi& E) {
    const int tid = otid(), wid = __builtin_amdgcn_readfirstlane(tid >> 6), lane = tid & 63, wr = wid >> 2, wc = wid & 3, fr = lane & 15, fq = lane >> 4;
    const int K = g.K, nt = K / BK;
    unsigned voffA[2], voffB[2];
#pragma unroll
    for (int i = 0; i < 2; ++i) { int R, C; stage_rc(tid * 16 + i * 8192, R, C); const int Rb = Epi::PERM ? ((R & ~31) + perm32(R & 31)) : R;
        voffA[i] = (unsigned)(R * K + C) * 2u; voffB[i] = (unsigned)(Rb * K + C) * 2u; }
    const size_t kstep = (size_t)(BK * 2);
    const size_t hstep = (size_t)HALF * K * 2;
    const size_t tstep = 2 * hstep;
    const unsigned ldsw = (unsigned)wid * 1024u;
    const int aoff = lds_byte(wr * 64 + fr, fq * 8), boff = lds_byte(wc * 32 + fr, fq * 8);
#define PG8_SA(b, h) (((b) * 2 + (h)) * HTB)
#define PG8_SB(b, h) ((4 + (b) * 2 + (h)) * HTB)
#define PG8_STAGE(bufoff, gbase, voff) do { _Pragma("unroll") for (int _i = 0; _i < 2; ++_i) \
        __builtin_amdgcn_global_load_lds((const unsigned*)((const char*)(gbase) + (voff)[_i]), (LAS unsigned*)(lds + (bufoff) + ldsw + _i * 8192), 16, 0, 0); } while (0)
#define PG8_LDA(dst, b, h) do { _Pragma("unroll") for (int m = 0; m < 4; ++m) _Pragma("unroll") for (int k = 0; k < 2; ++k) dst[m][k] = *(const LAS bf16x8*)(lds + PG8_SA(b, h) + aoff + m * 2048 + k * 1024); } while (0)
#define PG8_LDB(dst, b, h) do { _Pragma("unroll") for (int n = 0; n < 2; ++n) _Pragma("unroll") for (int k = 0; k < 2; ++k) dst[n][k] = *(const LAS bf16x8*)(lds + PG8_SB(b, h) + boff + n * 2048 + k * 1024); } while (0)
#define PG8_MMA(ai, bj, At, Bt) do { __builtin_amdgcn_s_setprio(1); _Pragma("unroll") for (int m = 0; m < 4; ++m) _Pragma("unroll") for (int n = 0; n < 2; ++n) _Pragma("unroll") for (int k = 0; k < 2; ++k) \
        acc[ai][bj][m][n] = __builtin_amdgcn_mfma_f32_16x16x32_bf16(Bt[n][k], At[m][k], acc[ai][bj][m][n], 0, 0, 0); __builtin_amdgcn_s_setprio(0); } while (0)
#define PG8_WAIT_V(n) asm volatile("s_waitcnt vmcnt(" #n ")" ::: "memory")
#define PG8_WAIT_L(n) asm volatile("s_waitcnt lgkmcnt(" #n ")" ::: "memory")
#define PG8_BAR __builtin_amdgcn_s_barrier()
#define PG8_SCHED __builtin_amdgcn_sched_barrier(0)
    Unit cur, nxt; int ui = 0;
    if (!S.next(0, cur)) return;
    f32x4 acc[2][2][4][2];
#pragma unroll
    for (int a = 0; a < 2; ++a)
#pragma unroll
        for (int b = 0; b < 2; ++b)
#pragma unroll
            for (int m = 0; m < 4; ++m)
#pragma unroll
                for (int n = 0; n < 2; ++n) acc[a][b][m][n] = (f32x4){0.f, 0.f, 0.f, 0.f};
    bf16x8 At[4][2], B0[2][2], B1[2][2];
    const char* cA = (const char*)g.A + (size_t)cur.pm * tstep; const char* cB = (const char*)g.Bt + (size_t)cur.pn * tstep;
    S.a_ready(cur);
    if constexpr (SP2) {
        PG8_STAGE(PG8_SB(0, 0), cB, voffB); PG8_STAGE(PG8_SB(0, 1), cB + hstep, voffB); PG8_STAGE(PG8_SA(0, 0), cA, voffA); PG8_STAGE(PG8_SA(0, 1), cA + hstep, voffA);
        if (wr == 1) PG8_BAR;
        PG8_WAIT_V(2); PG8_BAR;
        PG8_STAGE(PG8_SB(1, 0), cB + kstep, voffB); PG8_STAGE(PG8_SA(1, 0), cA + kstep, voffA); PG8_STAGE(PG8_SB(1, 1), cB + hstep + kstep, voffB);
        PG8_WAIT_V(6); PG8_BAR;
    } else {
        PG8_STAGE(PG8_SB(0, 0), cB, voffB); PG8_STAGE(PG8_SA(0, 0), cA, voffA); PG8_STAGE(PG8_SB(0, 1), cB + hstep, voffB); PG8_STAGE(PG8_SA(0, 1), cA + hstep, voffA);
        if (wr == 1) PG8_BAR;
        PG8_WAIT_V(4); PG8_BAR;
        PG8_STAGE(PG8_SB(1, 0), cB + kstep, voffB); PG8_STAGE(PG8_SA(1, 0), cA + kstep, voffA); PG8_STAGE(PG8_SB(1, 1), cB + hstep + kstep, voffB);
        PG8_WAIT_V(6); PG8_BAR;
    }
    for (;;) {
        const bool has_next = S.next(ui + 1, nxt);
        const char* nA = has_next ? (const char*)g.A + (size_t)nxt.pm * tstep : cA; const char* nB = has_next ? (const char*)g.Bt + (size_t)nxt.pn * tstep : cB;
        for (int t = 0; t < nt; t += 2) {
            const bool last = (t == nt - 2);
            const char* a1 = cA + (size_t)(t + 1) * kstep;
            const char* a2 = last ? nA : cA + (size_t)(t + 2) * kstep; const char* b2 = last ? nB : cB + (size_t)(t + 2) * kstep;
            const char* a3 = a2 + kstep; const char* b3 = b2 + kstep;
            if (last && has_next) S.a_ready(nxt);
            if constexpr (SP2) {
            PG8_LDB(B0, 0, 0); PG8_LDB(B1, 0, 1); PG8_SCHED; PG8_LDA(At, 0, 0); PG8_STAGE(PG8_SA(1, 1), a1 + hstep, voffA);
            PG8_WAIT_V(8); PG8_WAIT_L(0); PG8_BAR; PG8_MMA(0, 0, At, B0); PG8_MMA(0, 1, At, B1); PG8_BAR; PG8_SCHED;
            PG8_LDA(At, 0, 1); PG8_STAGE(PG8_SB(0, 0), b2, voffB); PG8_STAGE(PG8_SB(0, 1), b2 + hstep, voffB); PG8_STAGE(PG8_SA(0, 0), a2, voffA);
            PG8_WAIT_V(8); PG8_WAIT_L(0); PG8_BAR; PG8_MMA(1, 0, At, B0); PG8_MMA(1, 1, At, B1); PG8_BAR; PG8_SCHED;
            PG8_LDB(B0, 1, 0); PG8_LDB(B1, 1, 1); PG8_SCHED; PG8_LDA(At, 1, 0); PG8_STAGE(PG8_SA(0, 1), a2 + hstep, voffA);
            PG8_WAIT_V(8); PG8_WAIT_L(0); PG8_BAR; PG8_MMA(0, 0, At, B0); PG8_MMA(0, 1, At, B1); PG8_BAR; PG8_SCHED;
            PG8_LDA(At, 1, 1); PG8_STAGE(PG8_SB(1, 0), b3, voffB); PG8_STAGE(PG8_SB(1, 1), b3 + hstep, voffB); PG8_STAGE(PG8_SA(1, 0), a3, voffA);
            PG8_WAIT_V(8); PG8_WAIT_L(0); PG8_BAR; PG8_MMA(1, 0, At, B0); PG8_MMA(1, 1, At, B1); PG8_BAR; PG8_SCHED;
            } else {
            PG8_LDB(B0, 0, 0); PG8_SCHED; PG8_LDA(At, 0, 0); PG8_STAGE(PG8_SA(1, 1), a1 + hstep, voffA);
            PG8_WAIT_L(8); PG8_BAR; PG8_WAIT_L(0); PG8_MMA(0, 0, At, B0); PG8_BAR; PG8_SCHED;
            PG8_LDB(B1, 0, 1); PG8_STAGE(PG8_SB(0, 0), b2, voffB);
            PG8_BAR; PG8_WAIT_L(0); PG8_MMA(0, 1, At, B1); PG8_BAR;
            PG8_LDA(At, 0, 1); PG8_STAGE(PG8_SA(0, 0), a2, voffA);
            PG8_BAR; PG8_WAIT_L(0); PG8_MMA(1, 0, At, B0); PG8_BAR; PG8_SCHED;
            PG8_STAGE(PG8_SB(0, 1), b2 + hstep, voffB);
            PG8_WAIT_V(6); PG8_BAR; PG8_MMA(1, 1, At, B1); PG8_BAR;
            PG8_LDB(B0, 1, 0); PG8_SCHED; PG8_LDA(At, 1, 0); PG8_STAGE(PG8_SA(0, 1), a2 + hstep, voffA);
            PG8_WAIT_L(8); PG8_BAR; PG8_WAIT_L(0); PG8_MMA(0, 0, At, B0); PG8_BAR; PG8_SCHED;
            PG8_LDB(B1, 1, 1); PG8_STAGE(PG8_SB(1, 0), b3, voffB);
            PG8_BAR; PG8_WAIT_L(0); PG8_MMA(0, 1, At, B1); PG8_BAR;
            PG8_LDA(At, 1, 1); PG8_STAGE(PG8_SA(1, 0), a3, voffA);
            PG8_BAR; PG8_WAIT_L(0); PG8_MMA(1, 0, At, B0); PG8_BAR; PG8_SCHED;
            PG8_STAGE(PG8_SB(1, 1), b3 + hstep, voffB);
            PG8_WAIT_V(6); PG8_BAR; PG8_MMA(1, 1, At, B1); PG8_BAR;
            }
        }
        if constexpr (ALIGN_EPI) { if (wr == 0) PG8_BAR; }
        E(acc, cur, wr, wc, fr, fq); S.done(cur);
        if (!has_next) break;
#pragma unroll
        for (int a = 0; a < 2; ++a)
#pragma unroll
            for (int b = 0; b < 2; ++b)
#pragma unroll
                for (int m = 0; m < 4; ++m)
#pragma unroll
                    for (int n = 0; n < 2; ++n) acc[a][b][m][n] = (f32x4){0.f, 0.f, 0.f, 0.f};
        cur = nxt; cA = nA; cB = nB; ++ui;
        if constexpr (ALIGN_EPI) { if (wr == 1) PG8_BAR; }
    }
    PG8_WAIT_V(0);
    if constexpr (!ALIGN_EPI) { if (wr == 0) PG8_BAR; }
    PG8_BAR;
#undef PG8_SA
#undef PG8_SB
#undef PG8_STAGE
#undef PG8_LDA
#undef PG8_LDB
#undef PG8_MMA
#undef PG8_WAIT_V
#undef PG8_WAIT_L
#undef PG8_BAR
#undef PG8_SCHED
}
}
using pg8::Unit;

struct EpiB {
    static constexpr bool PERM = true;
    bf16_t *Q, *F, *I, *ZB, *GB;
    __device__ __forceinline__ void operator()(const f32x4 (&acc)[2][2][4][2], const Unit& u, int wr, int wc, int fr, int fq) const {
        const int seg = u.pn >> 2;
        bf16_t* base = seg == 0 ? Q : seg == 1 ? F : seg == 2 ? I : seg == 3 ? ZB : GB;
        const int col0 = (u.pn & 3) * 256 + wc * 32 + 8 * fq, row0 = u.pm * 256 + wr * 64 + fr;
#pragma unroll
        for (int ai = 0; ai < 2; ++ai)
#pragma unroll
            for (int m = 0; m < 4; ++m) { bf16_t* rowp = base + (size_t)(row0 + ai * 128 + m * 16) * D + col0;
#pragma unroll
                for (int bj = 0; bj < 2; ++bj) { float v[8];
#pragma unroll
                    for (int j = 0; j < 4; ++j) { v[j] = acc[ai][bj][m][0][j]; v[4 + j] = acc[ai][bj][m][1][j]; }
                    u32x4 w;
                    if (seg == 1) { w.x = pk_f16(v[0], v[1]); w.y = pk_f16(v[2], v[3]); w.z = pk_f16(v[4], v[5]); w.w = pk_f16(v[6], v[7]); }
                    else {
                        if (seg != 2) {
#pragma unroll
                            for (int j = 0; j < 8; ++j) { const float s = fsigmoid(v[j]); v[j] = (seg == 4) ? s : v[j] * s; } }
                        w.x = cvt_pk_bf16(v[0], v[1]); w.y = cvt_pk_bf16(v[2], v[3]); w.z = cvt_pk_bf16(v[4], v[5]); w.w = cvt_pk_bf16(v[6], v[7]); }
                    *(u32x4*)(rowp + bj * 128) = w; } }
    }
};
struct EpiA {
    static constexpr bool PERM = true;
    bf16_t *UZ, *V, *GA; float* stats;
    __device__ __forceinline__ void operator()(const f32x4 (&acc)[2][2][4][2], const Unit& u, int wr, int wc, int fr, int fq) const {
        const int row0 = u.pm * 256 + wr * 64 + fr;
        if (u.pn < 8) {
            const int col0 = u.pn * 128 + wc * 32 + 8 * fq;
#pragma unroll
            for (int ai = 0; ai < 2; ++ai)
#pragma unroll
                for (int m = 0; m < 4; ++m) { float v[8];
#pragma unroll
                    for (int j = 0; j < 4; ++j) { v[j] = fgelu(acc[ai][0][m][0][j]) * fsilu(acc[ai][1][m][0][j]); v[4 + j] = fgelu(acc[ai][0][m][1][j]) * fsilu(acc[ai][1][m][1][j]); }
                    u32x4 w; w.x = cvt_pk_bf16(v[0], v[1]); w.y = cvt_pk_bf16(v[2], v[3]); w.z = cvt_pk_bf16(v[4], v[5]); w.w = cvt_pk_bf16(v[6], v[7]);
                    *(u32x4*)(UZ + (size_t)(row0 + ai * 128 + m * 16) * D + col0) = w; }
        } else if (u.pn < 12) {
            const int pnl = u.pn - 8, col0 = pnl * 256 + wc * 32 + 8 * fq;
#pragma unroll
            for (int ai = 0; ai < 2; ++ai)
#pragma unroll
                for (int m = 0; m < 4; ++m) { const int row = row0 + ai * 128 + m * 16; float s = 0.f, ss = 0.f;
#pragma unroll
                    for (int bj = 0; bj < 2; ++bj) { float v[8];
#pragma unroll
                        for (int j = 0; j < 4; ++j) { v[j] = fgelu(acc[ai][bj][m][0][j]); v[4 + j] = fgelu(acc[ai][bj][m][1][j]); }
#pragma unroll
                        for (int j = 0; j < 8; ++j) { s += v[j]; ss += v[j] * v[j]; }
                        u32x4 w; w.x = cvt_pk_bf16(v[0], v[1]); w.y = cvt_pk_bf16(v[2], v[3]); w.z = cvt_pk_bf16(v[4], v[5]); w.w = cvt_pk_bf16(v[6], v[7]);
                        *(u32x4*)(V + (size_t)row * D + col0 + bj * 128) = w; }
                    s = xrow16_sum(s); ss = xrow16_sum(ss);
                    *(f32x2*)(stats + ((size_t)row * 16 + pnl * 4 + wc) * 2) = (f32x2){s, ss}; }
        } else {
            const int col0 = (u.pn - 12) * 256 + wc * 32 + 8 * fq;
#pragma unroll
            for (int ai = 0; ai < 2; ++ai)
#pragma unroll
                for (int m = 0; m < 4; ++m)
#pragma unroll
                    for (int bj = 0; bj < 2; ++bj) { float v[8];
#pragma unroll
                        for (int j = 0; j < 4; ++j) { v[j] = fsigmoid(acc[ai][bj][m][0][j]); v[4 + j] = fsigmoid(acc[ai][bj][m][1][j]); }
                        u32x4 w; w.x = cvt_pk_bf16(v[0], v[1]); w.y = cvt_pk_bf16(v[2], v[3]); w.z = cvt_pk_bf16(v[4], v[5]); w.w = cvt_pk_bf16(v[6], v[7]);
                        *(u32x4*)(GA + (size_t)(row0 + ai * 128 + m * 16) * D + col0 + bj * 128) = w; }
        }
    }
};
template <bool ADD> struct EpiGate {
    static constexpr bool PERM = true;
    const bf16_t* G; const bf16_t* T; bf16_t* O;
    __device__ __forceinline__ void operator()(const f32x4 (&acc)[2][2][4][2], const Unit& u, int wr, int wc, int fr, int fq) const {
        const int col0 = u.pn * 256 + wc * 32 + 8 * fq, row0 = u.pm * 256 + wr * 64 + fr;
#pragma unroll
        for (int ai = 0; ai < 2; ++ai)
#pragma unroll
            for (int m = 0; m < 4; ++m) { const size_t off = (size_t)(row0 + ai * 128 + m * 16) * D + col0;
#pragma unroll
                for (int bj = 0; bj < 2; ++bj) { const u32x4 gq = *(const u32x4*)(G + off + bj * 128);
                    const unsigned gw[4] = {gq.x, gq.y, gq.z, gq.w}; float v[8];
#pragma unroll
                    for (int j = 0; j < 2; ++j) { v[2 * j] = bf_lo(gw[j]) * acc[ai][bj][m][0][2 * j]; v[2 * j + 1] = bf_hi(gw[j]) * acc[ai][bj][m][0][2 * j + 1];
                        v[4 + 2 * j] = bf_lo(gw[2 + j]) * acc[ai][bj][m][1][2 * j]; v[5 + 2 * j] = bf_hi(gw[2 + j]) * acc[ai][bj][m][1][2 * j + 1]; }
                    if (ADD) { const u32x4 tq = *(const u32x4*)(T + off + bj * 128); const unsigned tw[4] = {tq.x, tq.y, tq.z, tq.w};
#pragma unroll
                        for (int j = 0; j < 4; ++j) { v[2 * j] += bf_lo(tw[j]); v[2 * j + 1] += bf_hi(tw[j]); } }
                    u32x4 w; w.x = cvt_pk_bf16(v[0], v[1]); w.y = cvt_pk_bf16(v[2], v[3]); w.z = cvt_pk_bf16(v[4], v[5]); w.w = cvt_pk_bf16(v[6], v[7]);
                    *(u32x4*)(O + off + bj * 128) = w; } }
    }
};
struct EpiO {
    static constexpr bool PERM = false;
    const float *xp, *xs; float* xo; const float* mod;
    __device__ __forceinline__ void operator()(const f32x4 (&acc)[2][2][4][2], const Unit& u, int wr, int wc, int fr, int fq) const {
        const unsigned col0 = (unsigned)(u.pn * 256 + wc * 32 + 4 * fq);
        const float* xt = ((u.pm < MP / 256) ? xp : xs - (size_t)MP * D) + (size_t)u.pm * 256 * D;
        float* ot = xo + (size_t)u.pm * 256 * D;
#pragma unroll
        for (int ai = 0; ai < 2; ++ai) {
            const int ci = cond_of_row(u.pm * 256 + ai * 128 + wr * 64);
            const float* gate = mod + (size_t)ci * 3 * D + 2 * D;
            f32x4 gv[2][2];
#pragma unroll
            for (int bj = 0; bj < 2; ++bj)
#pragma unroll
                for (int n = 0; n < 2; ++n) gv[bj][n] = *(const f32x4*)(gate + (col0 + bj * 128 + n * 16));
#pragma unroll
            for (int m = 0; m < 4; ++m) { const unsigned off = (unsigned)(ai * 128 + wr * 64 + m * 16 + fr) * D + col0;
#pragma unroll
                for (int bj = 0; bj < 2; ++bj)
#pragma unroll
                    for (int n = 0; n < 2; ++n) { const f32x4 xv = *(const f32x4*)(xt + (off + bj * 128 + n * 16));
                        *(f32x4*)(ot + (off + bj * 128 + n * 16)) = xv + gv[bj][n] * acc[ai][bj][m][n]; }
                asm volatile("" ::: "memory"); } }
    }
};


__device__ __forceinline__ int win_src_col(int n) {
    if (n < 4096) return 3072 + n;
    if (n < 5120) return 8192 + (n - 4096);
    n -= 5120;
    if (n < 2048) { const int t = n >> 8, r = n & 255; return r < 128 ? 128 * t + r : 2048 + 128 * t + (r - 128); }
    if (n < 3072) return 1024 + (n - 2048);
    return 7168 + (n - 3072);
}
__device__ __forceinline__ void transpose_item(const float* W, int ldn, int n0s, int k0, bf16_t* WT, int n0d, LAS float* scr, int lane) {
#pragma unroll 8
    for (int i = 0; i < 32; ++i) { const int kk = 2 * i + (lane >> 5); scr[kk * 33 + (lane & 31)] = W[(size_t)(k0 + kk) * ldn + n0s + (lane & 31)]; }
    __builtin_amdgcn_s_waitcnt(0xc07f); asm volatile("" ::: "memory");
    const int c = lane & 7;
#pragma unroll
    for (int j = 0; j < 4; ++j) { const int n = (lane >> 3) + 8 * j; const LAS float* s = scr + (8 * c) * 33 + n;
        u32x4 o; o.x = cvt_pk_bf16(s[0 * 33], s[1 * 33]); o.y = cvt_pk_bf16(s[2 * 33], s[3 * 33]); o.z = cvt_pk_bf16(s[4 * 33], s[5 * 33]); o.w = cvt_pk_bf16(s[6 * 33], s[7 * 33]);
        *(u32x4*)(WT + (size_t)(n0d + n) * D + k0 + 8 * c) = o; }
    __builtin_amdgcn_s_waitcnt(0xc07f); asm volatile("" ::: "memory");
}
__device__ __forceinline__ void phase_prep(CParams* p, LAS unsigned char* lds) {
    const int tid = otid(), lane = tid & 63, wave = tid >> 6, G = ogrid(), bid = obid();
    {
        LAS float* sc = (LAS float*)lds;
        LAS float* part = sc + 8192;
        for (int it = bid; it < 576; it += G) {
            const int l = it / 288, rg = (it % 288) / 48, cb = it % 48;
            __syncthreads();
            for (int e = tid; e < 8 * 1024; e += 512) { const int r = e >> 10, k = e & 1023, ci = rg * 8 + r;
                const float cv = ci < 16 ? p->c_prompt[(size_t)ci * D + k] : p->c_sample[(size_t)(ci - 16) * D + k]; sc[k * 8 + r] = fsilu(cv); }
            __syncthreads();
            const int col = cb * 64 + lane; const float* w = p->w_ada + (size_t)l * D * 3 * D + (size_t)(wave * 128) * 3 * D + col;
            float a[8] = {0.f, 0.f, 0.f, 0.f, 0.f, 0.f, 0.f, 0.f};
            for (int k8 = 0; k8 < 128; k8 += 8) { float wv[8];
#pragma unroll
                for (int u = 0; u < 8; ++u) wv[u] = w[(size_t)(k8 + u) * 3 * D];
#pragma unroll
                for (int u = 0; u < 8; ++u) { const LAS float* s = sc + (wave * 128 + k8 + u) * 8; const f32x4 s0 = *(const LAS f32x4*)s, s1 = *(const LAS f32x4*)(s + 4);
                    a[0] += s0.x * wv[u]; a[1] += s0.y * wv[u]; a[2] += s0.z * wv[u]; a[3] += s0.w * wv[u]; a[4] += s1.x * wv[u]; a[5] += s1.y * wv[u]; a[6] += s1.z * wv[u]; a[7] += s1.w * wv[u]; } }
#pragma unroll
            for (int r = 0; r < 8; ++r) part[(wave * 8 + r) * 64 + lane] = a[r];
            __syncthreads();
            { float s = 0.f;
#pragma unroll
              for (int w2 = 0; w2 < 8; ++w2) s += part[(w2 * 8 + wave) * 64 + lane];
              ((float*)(p->ws + WS_MOD))[((size_t)l * NCOND + rg * 8 + wave) * 3 * D + col] = s + p->b_ada[(size_t)l * 3 * D + col]; }
        }
        __syncthreads();
    }
    {
        LAS float* scr = (LAS float*)(lds + wave * 8704);
        const int gw = bid * 8 + wave, NGW = G * 8;
        constexpr int I_IN = 16 * (NIN / 32), I_SQ = 16 * (D / 32), PER_L = I_IN + 3 * I_SQ;
        for (int it = gw; it < 2 * PER_L; it += NGW) { const int l = it / PER_L; int r = it % PER_L;
            if (r < I_IN) { const int kb = r / (NIN / 32), nb = r % (NIN / 32);
                transpose_item(p->w_in + (size_t)l * D * NIN, NIN, win_src_col(nb * 32), kb * 64, (bf16_t*)(p->ws + WS_WIN) + (size_t)l * NIN * D, nb * 32, scr, lane); continue; }
            r -= I_IN; const int which = r / I_SQ; r %= I_SQ; const int kb = r / (D / 32), nb = r % (D / 32);
            const float* src = (which == 0 ? p->w_pa : which == 1 ? p->w_pb : p->w_o) + (size_t)l * D * D;
            bf16_t* dst = (bf16_t*)(p->ws + (which == 0 ? WS_WPA : which == 1 ? WS_WPB : WS_WO)) + (size_t)l * D * D;
            transpose_item(src, D, nb * 32, kb * 64, dst, nb * 32, scr, lane); }
    }
}

__device__ __forceinline__ void phase_norm(CParams* p, int l, const float* xp, const float* xs, bf16_t* H) {
    const int tid = otid(), lane = tid & 63, gw = obid() * 8 + (tid >> 6), NGW = ogrid() * 8;
    const float* g = p->norm_g + (size_t)l * D; const float* mod = (const float*)(p->ws + WS_MOD) + (size_t)l * NCOND * 3 * D;
    for (int row = gw; row < M; row += NGW) {
        const float* xr = row < MP ? xp + (size_t)row * D : xs + (size_t)(row - MP) * D;
        const float* mrow = mod + (size_t)cond_of_row(row) * 3 * D;
        f32x4 v[4]; float s = 0.f;
#pragma unroll
        for (int j = 0; j < 4; ++j) { v[j] = *(const f32x4*)(xr + 4 * lane + 256 * j); s += (v[j].x * v[j].x + v[j].y * v[j].y) + (v[j].z * v[j].z + v[j].w * v[j].w); }
        const float r = rsqrtf(wave_sum(s) * (1.f / D) + EPS);
#pragma unroll
        for (int j = 0; j < 4; ++j) { const int c = 4 * lane + 256 * j; const f32x4 gv = *(const f32x4*)(g + c), sh = *(const f32x4*)(mrow + c), sc = *(const f32x4*)(mrow + D + c);
            const f32x4 h = (v[j] * r) * gv * (sc + 1.0f) + sh;
            u32x2 w; w.x = cvt_pk_bf16(h.x, h.y); w.y = cvt_pk_bf16(h.z, h.w); *(u32x2*)(H + (size_t)row * D + c) = w; }
    }
}
__device__ __forceinline__ void phase_final(CParams* p) {
    const int tid = otid(), lane = tid & 63, gw = obid() * 8 + (tid >> 6), NGW = ogrid() * 8;
    for (int row = gw; row < M; row += NGW) {
        float* xr = p->out + OUT_Y + (size_t)row * D;
        f32x4 v[4]; float s = 0.f;
#pragma unroll
        for (int j = 0; j < 4; ++j) { v[j] = *(const f32x4*)(xr + 4 * lane + 256 * j); s += (v[j].x * v[j].x + v[j].y * v[j].y) + (v[j].z * v[j].z + v[j].w * v[j].w); }
        const float r = rsqrtf(wave_sum(s) * (1.f / D) + EPS);
#pragma unroll
        for (int j = 0; j < 4; ++j) { const int c = 4 * lane + 256 * j; const f32x4 gv = *(const f32x4*)(p->final_g + c); *(f32x4*)(xr + c) = (v[j] * r) * gv; }
    }
}

__device__ __forceinline__ void phase_scan(CParams* p, int l, const bf16_t* Q, const bf16_t* F, bf16_t* I, float* SQ, LAS unsigned char* lds) {
    const int tid = otid(), G = ogrid(), bid = obid();
    LAS float* fS = (LAS float*)lds; LAS float* kS = fS + 2048; LAS float* qS = kS + 2048; LAS float* iS = qS + 2048; LAS float* op = iS + 2048;
    const int lane = tid & 63, kg = lane & 15, vg = (tid >> 6) * 4 + (lane >> 4), k0 = kg * 8;
    const int st = tid >> 5, sc4 = (tid & 31) * 4, vl2 = (tid & 31) * 2;
    for (int it = bid; it < 768; it += G) {
        const bool prompt = it < 256; const int id = prompt ? it : it - 256, b = id >> 4, h = (id >> 1) & 7, vh = id & 1;
        const int T = prompt ? 2048 : 64, row0 = prompt ? b * 2048 : MP + b * 64, v0 = vh * 64 + vg * 2;
        float* sout = p->out + (prompt ? OUT_SP + ((size_t)(l * 16 + b) * 8 + h) * 16384 : OUT_SS + ((size_t)(l * 32 + b) * 8 + h) * 16384);
        f32x2 S[8];
        if (prompt) {
#pragma unroll
            for (int j = 0; j < 8; ++j) S[j] = (f32x2){0.f, 0.f};
        } else { const float* sin = p->state_hgrn + ((size_t)(l * 32 + b) * 8 + h) * 16384;
#pragma unroll
            for (int j = 0; j < 8; ++j) S[j] = *(const f32x2*)(sin + (k0 + j) * 128 + v0); }
        float lb[4];
#pragma unroll
        for (int j = 0; j < 4; ++j) { const int hk = h * 128 + sc4 + j; lb[j] = l == 0 ? 0.f : fsigmoid(p->lb_raw[D + hk] - p->lb_raw[hk]); }
        const size_t off0 = (size_t)(row0 + st) * D + h * 128 + sc4;
        u32x2 qw = *(const u32x2*)(Q + off0), fw = *(const u32x2*)(F + off0), iw = *(const u32x2*)(I + off0);
        auto stage = [&](int tnext) {
            *(LAS f32x4*)(qS + st * 128 + sc4) = (f32x4){bf_lo(qw.x), bf_hi(qw.x), bf_lo(qw.y), bf_hi(qw.y)};
            *(LAS f32x4*)(iS + st * 128 + sc4) = (f32x4){bf_lo(iw.x), bf_hi(iw.x), bf_lo(iw.y), bf_hi(iw.y)};
            const float z[4] = {f16_lo(fw.x), f16_hi(fw.x), f16_lo(fw.y), f16_hi(fw.y)}; f32x4 fv;
#pragma unroll
            for (int j = 0; j < 4; ++j) { const float sg = fsigmoid(z[j]); fv[j] = lb[j] + (1.f - lb[j]) * sg; }
            *(LAS f32x4*)(fS + st * 128 + sc4) = fv;
            if (tnext < T) { const size_t off = off0 + (size_t)tnext * D; qw = *(const u32x2*)(Q + off); fw = *(const u32x2*)(F + off); iw = *(const u32x2*)(I + off); }
        };
        __syncthreads();
        stage(16);
        for (int t0 = 0; t0 < T; t0 += 16) {
            __syncthreads();
            {
                f32x2 iv = *(const LAS f32x2*)(iS + v0);
                f32x4 fa = *(const LAS f32x4*)(fS + k0), fb = *(const LAS f32x4*)(fS + k0 + 4);
                f32x4 qa = *(const LAS f32x4*)(qS + k0), qb = *(const LAS f32x4*)(qS + k0 + 4);
                f32x2 oacc[16];
#pragma unroll
                for (int t = 0; t < 16; ++t) {
                    const int tn = (t + 1 < 16) ? t + 1 : t;
                    const f32x2 ivn = *(const LAS f32x2*)(iS + tn * 128 + v0);
                    const f32x4 fan = *(const LAS f32x4*)(fS + tn * 128 + k0), fbn = *(const LAS f32x4*)(fS + tn * 128 + k0 + 4);
                    const f32x4 qan = *(const LAS f32x4*)(qS + tn * 128 + k0), qbn = *(const LAS f32x4*)(qS + tn * 128 + k0 + 4);
                    f32x2 o = (f32x2){0.f, 0.f};
#pragma unroll
                    for (int j = 0; j < 4; ++j) { S[j] = (S[j] - iv) * fa[j] + iv; o += S[j] * qa[j]; S[4 + j] = (S[4 + j] - iv) * fb[j] + iv; o += S[4 + j] * qb[j]; }
                    oacc[t] = o;
                    iv = ivn; fa = fan; fb = fbn; qa = qan; qb = qbn;
                }
                const bool b0 = (kg & 1) != 0, b1 = (kg & 2) != 0, b2 = (kg & 4) != 0, b3 = (kg & 8) != 0;
                f32x2 a8[8], a4[4], a2[2];
#pragma unroll
                for (int j = 0; j < 8; ++j) { const f32x2 keep = b0 ? oacc[8 + j] : oacc[j], send = b0 ? oacc[j] : oacc[8 + j];
                    a8[j].x = keep.x + dpp_mov<0xB1>(send.x); a8[j].y = keep.y + dpp_mov<0xB1>(send.y); }
#pragma unroll
                for (int j = 0; j < 4; ++j) { const f32x2 keep = b1 ? a8[4 + j] : a8[j], send = b1 ? a8[j] : a8[4 + j];
                    a4[j].x = keep.x + dpp_mov<0x4E>(send.x); a4[j].y = keep.y + dpp_mov<0x4E>(send.y); }
#pragma unroll
                for (int j = 0; j < 2; ++j) { const f32x2 keep = b3 ? a4[2 + j] : a4[j], send = b3 ? a4[j] : a4[2 + j];
                    a2[j].x = keep.x + dpp_mov<0x128>(send.x); a2[j].y = keep.y + dpp_mov<0x128>(send.y); }
                { const f32x2 keep = b2 ? a2[1] : a2[0], send = b2 ? a2[0] : a2[1]; f32x2 r;
                  r.x = keep.x + dpp_mov<0x1B>(dpp_mov<0x141>(send.x)); r.y = keep.y + dpp_mov<0x1B>(dpp_mov<0x141>(send.y));
                  const int tok = (b0 ? 8 : 0) + (b1 ? 4 : 0) + (b3 ? 2 : 0) + (b2 ? 1 : 0);
                  *(LAS f32x2*)(op + tok * 64 + vg * 2) = r; }
            }
            __syncthreads();
            { const f32x2 o = *(const LAS f32x2*)(op + st * 64 + vl2); float ss = o.x * o.x + o.y * o.y;
#pragma unroll
              for (int w = 1; w < 32; w <<= 1) ss += __shfl_xor(ss, w);
              const int row = row0 + t0 + st;
              if ((tid & 31) == 0) SQ[((size_t)row * 8 + h) * 2 + vh] = ss;
              *(unsigned*)(I + (size_t)row * D + h * 128 + vh * 64 + vl2) = cvt_pk_bf16(o.x, o.y); }
            if (t0 + 16 < T) stage(t0 + 32);
        }
#pragma unroll
        for (int j = 0; j < 8; ++j) *(f32x2*)(sout + (k0 + j) * 128 + v0) = S[j];
    }
}
__device__ __forceinline__ void phase_hnorm(CParams* p, int l, const bf16_t* O, bf16_t* Q, const bf16_t* ZB, const float* SQ) {
    const int tid = otid(), G = ogrid(), bid = obid();
    const float* gnp = p->gnorm_g + (size_t)l * D;
    for (int idx = bid * 512 + tid; idx < M * 128; idx += G * 512) {
        const int row = idx >> 7, c8 = (idx & 127) * 8, h = c8 >> 7;
        const f32x2 sq = *(const f32x2*)(SQ + ((size_t)row * 8 + h) * 2);
        const float r = rsqrtf((sq.x + sq.y) * (1.f / 128.f) + EPS);
        const u32x4 ow = *(const u32x4*)(O + (size_t)row * D + c8), zw = *(const u32x4*)(ZB + (size_t)row * D + c8);
        const f32x4 g0 = *(const f32x4*)(gnp + c8), g1 = *(const f32x4*)(gnp + c8 + 4);
        const unsigned oa[4] = {ow.x, ow.y, ow.z, ow.w}, za[4] = {zw.x, zw.y, zw.z, zw.w}; const float ga[8] = {g0.x, g0.y, g0.z, g0.w, g1.x, g1.y, g1.z, g1.w};
        u32x4 w; unsigned wa[4];
#pragma unroll
        for (int j = 0; j < 4; ++j) wa[j] = cvt_pk_bf16((bf_lo(oa[j]) * r) * ga[2 * j] * bf_lo(za[j]), (bf_hi(oa[j]) * r) * ga[2 * j + 1] * bf_hi(za[j]));
        w.x = wa[0]; w.y = wa[1]; w.z = wa[2]; w.w = wa[3];
        *(u32x4*)(Q + (size_t)row * D + c8) = w;
    }
}

__device__ __forceinline__ void phase_gmlp(CParams* p, int l, bf16_t* UZ, const bf16_t* V, LAS unsigned char* lds) {
    const int tid = otid(), G = ogrid(), bid = obid();
    constexpr int STR = 272;
    LAS unsigned char* vnT = lds;
    LAS unsigned char* Wb = lds + 256 * STR;
    LAS float* rs = (LAS float*)(lds + 384 * STR);
    const float* stats = (const float*)(p->ws + WS_STATS);
    const int lane = tid & 63, wave = tid >> 6, fr = lane & 15, fq = lane >> 4;
    int g_staged = -1;
    for (int it = bid; it < 288 * 4; it += G) {
        const int cix = it >> 2, g = it & 3, cb = g * 256;
        const bool prompt = cix < 256; const int R = prompt ? 128 : 64, row0 = prompt ? cix * 128 : MP + (cix - 256) * 64;
        __syncthreads();
        u32x4 vq[8];
#pragma unroll
        for (int i = 0; i < 8; ++i) { const int u = tid + 512 * i;
            if (u < R * 32) { const int s = prompt ? (u & 127) : (u & 63), c8 = (prompt ? (u >> 7) : (u >> 6)) * 8; vq[i] = *(const u32x4*)(V + (size_t)(row0 + s) * D + cb + c8); } }
        if (tid < R) { const float* sp = stats + (size_t)(row0 + tid) * 32; float s = 0.f, ss = 0.f;
#pragma unroll
            for (int j = 0; j < 16; ++j) { const f32x2 a2 = *(const f32x2*)(sp + 2 * j); s += a2.x; ss += a2.y; }
            const float mu = s * (1.f / D), var = fmaxf(ss * (1.f / D) - mu * mu, 0.f); rs[2 * tid] = mu; rs[2 * tid + 1] = rsqrtf(var + EPS); }
        if (g != g_staged) { g_staged = g; const float* wsrc = p->w_s + (size_t)(l * 4 + g) * 16384;
#pragma unroll
          for (int i = 0; i < 8; ++i) { const int u = tid + 512 * i, t = u >> 5, s4 = (u & 31) * 4; f32x4 w4 = *(const f32x4*)(wsrc + t * 128 + s4);
              w4.x = (s4 + 0 <= t) ? w4.x : 0.f; w4.y = (s4 + 1 <= t) ? w4.y : 0.f; w4.z = (s4 + 2 <= t) ? w4.z : 0.f; w4.w = (s4 + 3 <= t) ? w4.w : 0.f;
              u32x2 q; q.x = cvt_pk_bf16(w4.x, w4.y); q.y = cvt_pk_bf16(w4.z, w4.w); *(LAS u32x2*)(Wb + t * STR + s4 * 2) = q; } }
        __syncthreads();
#pragma unroll
        for (int i = 0; i < 8; ++i) { const int u = tid + 512 * i;
            if (u < R * 32) { const int s = prompt ? (u & 127) : (u & 63), c8 = (prompt ? (u >> 7) : (u >> 6)) * 8;
            const u32x4 q = vq[i]; const float mu = rs[2 * s], rstd = rs[2 * s + 1];
            const float* lg = p->ln_v_g + (size_t)l * D + cb + c8; const float* lbp = p->ln_v_b + (size_t)l * D + cb + c8;
            const f32x4 g0 = *(const f32x4*)lg, g1 = *(const f32x4*)(lg + 4), b0 = *(const f32x4*)lbp, b1 = *(const f32x4*)(lbp + 4);
            f32x4 x0 = (f32x4){bf_lo(q.x), bf_hi(q.x), bf_lo(q.y), bf_hi(q.y)}, x1 = (f32x4){bf_lo(q.z), bf_hi(q.z), bf_lo(q.w), bf_hi(q.w)};
            x0 = (x0 - mu) * rstd * g0 + b0; x1 = (x1 - mu) * rstd * g1 + b1;
            const unsigned pa = cvt_pk_bf16(x0.x, x0.y), pb = cvt_pk_bf16(x0.z, x0.w), pc = cvt_pk_bf16(x1.x, x1.y), pd = cvt_pk_bf16(x1.z, x1.w);
            LAS unsigned short* dst = (LAS unsigned short*)(vnT + c8 * STR + s * 2);
            dst[0] = (unsigned short)(pa & 0xffffu); dst[STR / 2] = (unsigned short)(pa >> 16); dst[2 * (STR / 2)] = (unsigned short)(pb & 0xffffu); dst[3 * (STR / 2)] = (unsigned short)(pb >> 16);
            dst[4 * (STR / 2)] = (unsigned short)(pc & 0xffffu); dst[5 * (STR / 2)] = (unsigned short)(pc >> 16); dst[6 * (STR / 2)] = (unsigned short)(pd & 0xffffu); dst[7 * (STR / 2)] = (unsigned short)(pd >> 16);
            if (!prompt) { float* vo = p->out + OUT_VS + ((size_t)(l * 32 + (cix - 256)) * 64 + s) * D + cb + c8; *(f32x4*)vo = x0; *(f32x4*)(vo + 4) = x1; } } }
        const int t0 = wave * 16, t = t0 + fr;
        bf16_t* urow = UZ + (size_t)(row0 + t) * D + cb + 4 * fq;
        u32x2 uzr[16]; float bias = 0.f;
        if (t0 < R) { bias = p->b_s[(size_t)(l * 4 + g) * 128 + t];
#pragma unroll
            for (int c = 0; c < 16; ++c) uzr[c] = *(const u32x2*)(urow + c * 16); }
        __syncthreads();
        if (t0 < R) {
            f32x4 acc[16];
#pragma unroll
            for (int c = 0; c < 16; ++c) acc[c] = (f32x4){0.f, 0.f, 0.f, 0.f};
            const int nsteps = (t0 + 15) / 32 + 1;
            for (int ks = 0; ks < nsteps; ++ks) { const int soff = (32 * ks + 8 * fq) * 2;
                const bf16x8 Bf = *(const LAS bf16x8*)(Wb + (t0 + fr) * STR + soff);
#pragma unroll
                for (int c = 0; c < 16; ++c) { const bf16x8 Af = *(const LAS bf16x8*)(vnT + (c * 16 + fr) * STR + soff); acc[c] = __builtin_amdgcn_mfma_f32_16x16x32_bf16(Af, Bf, acc[c], 0, 0, 0); } }
#pragma unroll
            for (int c = 0; c < 16; ++c) { const u32x2 uz = uzr[c];
                u32x2 w; w.x = cvt_pk_bf16(bf_lo(uz.x) * (acc[c].x + bias), bf_hi(uz.x) * (acc[c].y + bias)); w.y = cvt_pk_bf16(bf_lo(uz.y) * (acc[c].z + bias), bf_hi(uz.y) * (acc[c].w + bias));
                *(u32x2*)(urow + c * 16) = w; }
        }
    }
}

__device__ __forceinline__ void grid_barrier(unsigned* ctr, unsigned target) {
    asm volatile("s_waitcnt vmcnt(0)" ::: "memory");
    __syncthreads();
    if (threadIdx.x == 0) {
        __builtin_amdgcn_fence(__ATOMIC_RELEASE, "agent");
        asm volatile("s_waitcnt vmcnt(0)" ::: "memory");
        (void)__hip_atomic_fetch_add(ctr, 1u, __ATOMIC_RELAXED, __HIP_MEMORY_SCOPE_AGENT);
        unsigned sp = 0u;
        while (__hip_atomic_load(ctr, __ATOMIC_RELAXED, __HIP_MEMORY_SCOPE_AGENT) < target) { __builtin_amdgcn_s_sleep(1); if (++sp > (1u << 22)) break; }
        __builtin_amdgcn_fence(__ATOMIC_ACQUIRE, "agent");
        asm volatile("s_waitcnt vmcnt(0)" ::: "memory");
    }
    __syncthreads();
}

__global__ void __launch_bounds__(512) fwd_kernel(Params p_arg) {
    extern __shared__ __attribute__((aligned(16))) unsigned char shm[];
    LAS unsigned char* lds = (LAS unsigned char*)shm;
    const int ph_lo = p_arg.ph_lo, ph_hi = p_arg.ph_hi;
    for (int ph = ph_lo; ph < ph_hi; ++ph) {
        CParams* p = (CParams*)__builtin_amdgcn_kernarg_segment_ptr(); asm volatile("" : "+s"(p));
        unsigned char* ws = p->ws;
        bf16_t* B0 = (bf16_t*)(ws + WS_BUF); bf16_t* B1 = B0 + (size_t)M * D; bf16_t* B2 = B1 + (size_t)M * D; bf16_t* B3 = B2 + (size_t)M * D; bf16_t* B4 = B3 + (size_t)M * D; bf16_t* B5 = B4 + (size_t)M * D;
        float* xbuf = p->out + OUT_Y;
        const int G = ogrid(), bid = obid();
        if (ph == 0) { if (bid == 0 && threadIdx.x == 0) __hip_atomic_store((unsigned*)(ws + WS_BAR), 0u, __ATOMIC_RELAXED, __HIP_MEMORY_SCOPE_AGENT); phase_prep(p, lds); }
        else if (ph == 19) phase_final(p);
        else {
            const int l = (ph - 1) / 9, sub = (ph - 1) % 9;
            const float* xp = l == 0 ? p->x_prompt : xbuf; const float* xs = l == 0 ? p->x_sample : xbuf + (size_t)MP * D;
            const bf16_t* WinT = (const bf16_t*)(ws + WS_WIN) + (size_t)l * NIN * D;
            pg8::StaticOrder S;
            if (sub == 0) phase_norm(p, l, xp, xs, B0);
            else if (sub == 1) { pg8::Gemm g{B0, WinT, M, NB_COLS, D}; S.init(M, NB_COLS, G, bid); EpiB E{B1, B2, B3, B5, B4};
                pg8::gemm_phase<EpiB, pg8::StaticOrder, true, true>(lds, g, S, E); }
            else if (sub == 2) phase_scan(p, l, B1, B2, B3, (float*)(ws + WS_STATS), lds);
            else if (sub == 3) phase_hnorm(p, l, B3, B1, B5, (const float*)(ws + WS_STATS));
            else if (sub == 4) { pg8::Gemm g{B1, (const bf16_t*)(ws + WS_WPB) + (size_t)l * D * D, M, D, D}; S.init(M, D, G, bid); EpiGate<false> E{B4, nullptr, B2};
                pg8::gemm_phase<EpiGate<false>, pg8::StaticOrder, true, true>(lds, g, S, E); }
            else if (sub == 5) { pg8::Gemm g{B0, WinT + (size_t)NB_COLS * D, M, NA_COLS, D}; S.init(M, NA_COLS, G, bid); EpiA E{B3, B5, B4, (float*)(ws + WS_STATS)};
                pg8::gemm_phase<EpiA, pg8::StaticOrder, true, true>(lds, g, S, E); }
            else if (sub == 6) phase_gmlp(p, l, B3, B5, lds);
            else if (sub == 7) { pg8::Gemm g{B3, (const bf16_t*)(ws + WS_WPA) + (size_t)l * D * D, M, D, D}; S.init(M, D, G, bid); EpiGate<true> E{B4, B2, B5};
                pg8::gemm_phase<EpiGate<true>, pg8::StaticOrder, true, true>(lds, g, S, E); }
            else { pg8::Gemm g{B5, (const bf16_t*)(ws + WS_WO) + (size_t)l * D * D, M, D, D}; S.init(M, D, G, bid);
                EpiO E{xp, xs, xbuf, (const float*)(ws + WS_MOD) + (size_t)l * NCOND * 3 * D};
                pg8::gemm_phase<EpiO, pg8::StaticOrder, true, true>(lds, g, S, E); }
        }
#if MK_ONE_LAUNCH
        if (ph + 1 < ph_hi) { if (ph == 0) cg::this_grid().sync(); else grid_barrier((unsigned*)(ws + WS_BAR), (unsigned)ph * (unsigned)G); }
#endif
    }
}


extern "C" void kernel_launch(void* const* d_in, const int* in_sizes, int n_in, void* d_out, int out_size, void* d_ws, size_t ws_size, hipStream_t stream) {
    static int grid = 0;
    if (grid == 0) {
        if (n_in != 19 || ws_size < WS_END) { fprintf(stderr, "kernel_launch: need 19 inputs and %zu bytes of workspace; got %d, %zu\n", (size_t)WS_END, n_in, ws_size); grid = -1; return; }
        if (hipFuncSetAttribute((const void*)fwd_kernel, hipFuncAttributeMaxDynamicSharedMemorySize, LDS_BYTES) != hipSuccess) { fprintf(stderr, "kernel_launch: hipFuncSetAttribute failed\n"); grid = -1; return; }
        int dev = 0, cus = 0, per_cu = 0;
        hipGetDevice(&dev); hipDeviceGetAttribute(&cus, hipDeviceAttributeMultiprocessorCount, dev);
        hipOccupancyMaxActiveBlocksPerMultiprocessor(&per_cu, (const void*)fwd_kernel, 512, LDS_BYTES);
        if (per_cu < 1) { fprintf(stderr, "kernel_launch: occupancy query says %d blocks per CU\n", per_cu); per_cu = 1; }
        (void)hipGetLastError();
        grid = cus;
    }
    if (grid < 0) return;
    Params p{};
    const float** pp = (const float**)&p;
    for (int i = 0; i < 19; ++i) pp[i] = (const float*)d_in[i];
    p.out = (float*)d_out; p.ws = (unsigned char*)d_ws;
#if MK_ONE_LAUNCH
    p.ph_lo = 0; p.ph_hi = 20;
    void* args[] = {&p};
    hipError_t e = hipLaunchCooperativeKernel((const void*)fwd_kernel, dim3(grid), dim3(512), args, LDS_BYTES, stream);
    if (e != hipSuccess) fprintf(stderr, "cooperative launch failed: %s (grid %d)\n", hipGetErrorString(e), grid);
#else
    for (int ph = 0; ph < 20; ++ph) { p.ph_lo = ph; p.ph_hi = ph + 1; hipLaunchKernelGGL(fwd_kernel, dim3(grid), dim3(512), LDS_BYTES, stream, p); }
#endif
}
```

```cpp
#include <hip/hip_runtime.h>
#include <hip/hip_cooperative_groups.h>
#include <cstdio>
#include <cstdint>
namespace cg = cooperative_groups;

#ifndef MK_ONE_LAUNCH
#define MK_ONE_LAUNCH 1
#endif

#define LAS __attribute__((address_space(3)))
typedef unsigned short bf16_t;
typedef short bf16x8 __attribute__((ext_vector_type(8)));
typedef float f32x4 __attribute__((ext_vector_type(4)));
typedef float f32x2 __attribute__((ext_vector_type(2)));
typedef unsigned u32x4 __attribute__((ext_vector_type(4)));
typedef unsigned u32x2 __attribute__((ext_vector_type(2)));
typedef _Float16 f16x2 __attribute__((ext_vector_type(2)));

constexpr int D = 1024, MP = 32768, MS = 2048, M = MP + MS, NCOND = 48, NIN = 9216;
constexpr int NB_COLS = 5120, NA_COLS = 4096;
constexpr float EPS = 1e-6f;
constexpr size_t OUT_Y = 0, OUT_SP = (size_t)M * D, OUT_SS = OUT_SP + (size_t)2 * 16 * 8 * 16384, OUT_VS = OUT_SS + (size_t)2 * 32 * 8 * 16384;
constexpr size_t BUF_BYTES = (size_t)M * D * 2;
constexpr size_t WS_WIN = 0;
constexpr size_t WS_WPA = WS_WIN + (size_t)2 * NIN * D * 2;
constexpr size_t WS_WPB = WS_WPA + (size_t)2 * D * D * 2;
constexpr size_t WS_WO = WS_WPB + (size_t)2 * D * D * 2;
constexpr size_t WS_MOD = WS_WO + (size_t)2 * D * D * 2;
constexpr size_t WS_WTP = WS_MOD + (size_t)2 * NCOND * 3 * D * 4;
constexpr size_t WS_STATS = WS_WTP + (size_t)2 * 4 * 16384 * 4;
constexpr size_t WS_BUF = (WS_STATS + (size_t)M * 16 * 2 * 4 + 4095) & ~(size_t)4095;
constexpr size_t WS_BAR = WS_BUF + 6 * BUF_BYTES;
constexpr size_t WS_END = WS_BAR + 256;
constexpr int LDS_BYTES = 131072 + 4096;

struct Params {
    const float *x_prompt, *x_sample, *state_hgrn, *c_prompt, *c_sample, *w_ada, *b_ada, *norm_g, *w_in, *ln_v_g, *ln_v_b, *w_s, *b_s, *lb_raw, *gnorm_g, *w_pa, *w_pb, *w_o, *final_g;
    float* out; unsigned char* ws;
    int ph_lo, ph_hi;
};

typedef const Params __attribute__((address_space(4))) CParams;
typedef __bf16 bf16x2_t __attribute__((ext_vector_type(2)));
__device__ __forceinline__ unsigned cvt_pk_bf16(float lo, float hi) { const f32x2 v = {lo, hi}; const bf16x2_t h = __builtin_convertvector(v, bf16x2_t); return __builtin_bit_cast(unsigned, h); }
__device__ __forceinline__ float bf_lo(unsigned u) { return __uint_as_float(u << 16); }
__device__ __forceinline__ float bf_hi(unsigned u) { return __uint_as_float(u & 0xffff0000u); }
__device__ __forceinline__ unsigned pk_f16(float a, float b) { f16x2 h; h.x = (_Float16)a; h.y = (_Float16)b; return __builtin_bit_cast(unsigned, h); }
__device__ __forceinline__ float f16_lo(unsigned u) { f16x2 h = __builtin_bit_cast(f16x2, u); return (float)h.x; }
__device__ __forceinline__ float f16_hi(unsigned u) { f16x2 h = __builtin_bit_cast(f16x2, u); return (float)h.y; }
__device__ __forceinline__ float fsigmoid(float x) { return __builtin_amdgcn_rcpf(1.0f + __expf(-x)); }
__device__ __forceinline__ float fsilu(float x) { return x * fsigmoid(x); }
__device__ __forceinline__ float fgelu(float x) { return x * fsigmoid(1.5957691216057308f * (x + 0.044715f * x * x * x)); }
__device__ __forceinline__ float fgelu_silu(float u, float z) {
    const float a = 1.5957691216057308f * (u + 0.044715f * u * u * u);
    return (u * z) * __builtin_amdgcn_rcpf((1.0f + __expf(-a)) * (1.0f + __expf(-z)));
}
__device__ __forceinline__ float wave_sum(float v) {
#pragma unroll
    for (int o = 1; o < 64; o <<= 1) v += __shfl_xor(v, o);
    return v;
}
__device__ __forceinline__ int otid() { int t = threadIdx.x; asm volatile("" : "+v"(t)); return t; }
__device__ __forceinline__ int obid() { int b = blockIdx.x; asm volatile("" : "+s"(b)); return b; }
__device__ __forceinline__ int ogrid() { int g = gridDim.x; asm volatile("" : "+s"(g)); return g; }
__device__ __forceinline__ float xrow16_sum(float x) {
    auto s = __builtin_amdgcn_permlane16_swap(__float_as_uint(x), __float_as_uint(x), false, false);
    x = __uint_as_float(s[0]) + __uint_as_float(s[1]);
    auto t = __builtin_amdgcn_permlane32_swap(__float_as_uint(x), __float_as_uint(x), false, false);
    return __uint_as_float(t[0]) + __uint_as_float(t[1]);
}
template <int CTRL> __device__ __forceinline__ float dpp_mov(float x) { return __builtin_bit_cast(float, __builtin_amdgcn_mov_dpp(__builtin_bit_cast(int, x), CTRL, 0xf, 0xf, true)); }
__device__ __forceinline__ float row16_sum(float x) {
    x += dpp_mov<0xB1>(x); x += dpp_mov<0x4E>(x); x += dpp_mov<0x124>(x); x += dpp_mov<0x128>(x); return x;
}
__device__ __forceinline__ int cond_of_row(int r) { return r < MP ? (r >> 11) : 16 + ((r - MP) >> 6); }

namespace pg8 {
constexpr int BM = 256, BK = 64, HALF = 128, HTB = HALF * BK * 2, STAGE_BYTES = 8 * HTB, NXCD = 8, WGM = 8;
__host__ __device__ __forceinline__ int lds_byte(int r, int c) { const int st = (r >> 4) * 2 + (c >> 5), rr = r & 15, cc = c & 31, ob = rr * 64 + cc * 2; return st * 1024 + (ob ^ (((ob >> 9) & 1) << 5)); }
__host__ __device__ __forceinline__ void stage_rc(int b, int& R, int& C) { const int st = b / 1024, sb = b % 1024, swz = sb ^ (((sb >> 9) & 1) << 5); R = (st >> 1) * 16 + swz / 64; C = (st & 1) * 32 + (swz % 64) / 2; }
__host__ __device__ __forceinline__ int perm32(int rho) { const int n = rho >> 4, i = rho & 15; return 8 * (i >> 2) + 4 * n + (i & 3); }
struct Unit { int pm, pn; };
struct Gemm { const bf16_t* A; const bf16_t* Bt; int M, N, K; };
struct StaticOrder {
    int nM, nN, nwg, G, c;
    __host__ __device__ void init(int M_, int N_, int G_, int c_) { nM = M_ / BM; nN = N_ / BM; nwg = nM * nN; G = G_; c = c_; }
    __host__ __device__ bool next(int i, Unit& u) const {
        const long L = (long)i * G + c; if (L >= nwg) return false;
        int wgid = (int)L; { const int q = nwg / NXCD, r = nwg % NXCD, xcd = wgid % NXCD, off = wgid / NXCD; wgid = (xcd < r ? xcd * (q + 1) : r * (q + 1) + (xcd - r) * q) + off; }
        const int nig = WGM * nN, gid = wgid / nig, fm = gid * WGM, gsz = (nM - fm) < WGM ? (nM - fm) : WGM;
        u.pm = fm + ((wgid % nig) % gsz); u.pn = (wgid % nig) / gsz; return true;
    }
    __device__ __forceinline__ void a_ready(const Unit&) const {}
    __device__ __forceinline__ void done(const Unit&) const {}
};

template <class Epi, class Sched, bool ALIGN_EPI = false, bool SP2 = false>
__device__ __forceinline__ void gemm_phase(LAS unsigned char* lds, const Gemm g, const Sched& S, const Epi& E) {
    const int tid = otid(), wid = __builtin_amdgcn_readfirstlane(tid >> 6), lane = tid & 63, wr = wid >> 2, wc = wid & 3, fr = lane & 15, fq = lane >> 4;
    const int K = g.K, nt = K / BK;
    unsigned voffA[2], voffB[2];
#pragma unroll
    for (int i = 0; i < 2; ++i) { int R, C; stage_rc(tid * 16 + i * 8192, R, C); const int Rb = Epi::PERM ? ((R & ~31) + perm32(R & 31)) : R;
        voffA[i] = (unsigned)(R * K + C) * 2u; voffB[i] = (unsigned)(Rb * K + C) * 2u; }
    const size_t kstep = (size_t)(BK * 2);
    const size_t hstep = (size_t)HALF * K * 2;
    const size_t tstep = 2 * hstep;
    const unsigned ldsw = (unsigned)wid * 1024u;
    const int aoff = lds_byte(wr * 64 + fr, fq * 8), boff = lds_byte(wc * 32 + fr, fq * 8);
#define PG8_SA(b, h) (((b) * 2 + (h)) * HTB)
#define PG8_SB(b, h) ((4 + (b) * 2 + (h)) * HTB)
#define PG8_STAGE(bufoff, gbase, voff) do { _Pragma("unroll") for (int _i = 0; _i < 2; ++_i) \
        __builtin_amdgcn_global_load_lds((const unsigned*)((const char*)(gbase) + (voff)[_i]), (LAS unsigned*)(lds + (bufoff) + ldsw + _i * 8192), 16, 0, 0); } while (0)
#define PG8_LDA(dst, b, h) do { _Pragma("unroll") for (int m = 0; m < 4; ++m) _Pragma("unroll") for (int k = 0; k < 2; ++k) dst[m][k] = *(const LAS bf16x8*)(lds + PG8_SA(b, h) + aoff + m * 2048 + k * 1024); } while (0)
#define PG8_LDB(dst, b, h) do { _Pragma("unroll") for (int n = 0; n < 2; ++n) _Pragma("unroll") for (int k = 0; k < 2; ++k) dst[n][k] = *(const LAS bf16x8*)(lds + PG8_SB(b, h) + boff + n * 2048 + k * 1024); } while (0)
#define PG8_MMA(ai, bj, At, Bt) do { __builtin_amdgcn_s_setprio(1); _Pragma("unroll") for (int m = 0; m < 4; ++m) _Pragma("unroll") for (int n = 0; n < 2; ++n) _Pragma("unroll") for (int k = 0; k < 2; ++k) \
        acc[ai][bj][m][n] = __builtin_amdgcn_mfma_f32_16x16x32_bf16(Bt[n][k], At[m][k], acc[ai][bj][m][n], 0, 0, 0); __builtin_amdgcn_s_setprio(0); } while (0)
#define PG8_WAIT_V(n) asm volatile("s_waitcnt vmcnt(" #n ")" ::: "memory")
#define PG8_WAIT_L(n) asm volatile("s_waitcnt lgkmcnt(" #n ")" ::: "memory")
#define PG8_BAR __builtin_amdgcn_s_barrier()
#define PG8_SCHED __builtin_amdgcn_sched_barrier(0)
    Unit cur, nxt; int ui = 0;
    if (!S.next(0, cur)) return;
    f32x4 acc[2][2][4][2];
#pragma unroll
    for (int a = 0; a < 2; ++a)
#pragma unroll
        for (int b = 0; b < 2; ++b)
#pragma unroll
            for (int m = 0; m < 4; ++m)
#pragma unroll
                for (int n = 0; n < 2; ++n) acc[a][b][m][n] = (f32x4){0.f, 0.f, 0.f, 0.f};
    bf16x8 At[4][2], B0[2][2], B1[2][2];
    const char* cA = (const char*)g.A + (size_t)cur.pm * tstep; const char* cB = (const char*)g.Bt + (size_t)cur.pn * tstep;
    S.a_ready(cur);
    if constexpr (SP2) {
        PG8_STAGE(PG8_SB(0, 0), cB, voffB); PG8_STAGE(PG8_SB(0, 1), cB + hstep, voffB); PG8_STAGE(PG8_SA(0, 0), cA, voffA); PG8_STAGE(PG8_SA(0, 1), cA + hstep, voffA);
        if (wr == 1) PG8_BAR;
        PG8_WAIT_V(2); PG8_BAR;
        PG8_STAGE(PG8_SB(1, 0), cB + kstep, voffB); PG8_STAGE(PG8_SA(1, 0), cA + kstep, voffA); PG8_STAGE(PG8_SB(1, 1), cB + hstep + kstep, voffB);
        PG8_WAIT_V(6); PG8_BAR;
    } else {
        PG8_STAGE(PG8_SB(0, 0), cB, voffB); PG8_STAGE(PG8_SA(0, 0), cA, voffA); PG8_STAGE(PG8_SB(0, 1), cB + hstep, voffB); PG8_STAGE(PG8_SA(0, 1), cA + hstep, voffA);
        if (wr == 1) PG8_BAR;
        PG8_WAIT_V(4); PG8_BAR;
        PG8_STAGE(PG8_SB(1, 0), cB + kstep, voffB); PG8_STAGE(PG8_SA(1, 0), cA + kstep, voffA); PG8_STAGE(PG8_SB(1, 1), cB + hstep + kstep, voffB);
        PG8_WAIT_V(6); PG8_BAR;
    }
    for (;;) {
        const bool has_next = S.next(ui + 1, nxt);
        const char* nA = has_next ? (const char*)g.A + (size_t)nxt.pm * tstep : cA; const char* nB = has_next ? (const char*)g.Bt + (size_t)nxt.pn * tstep : cB;
        for (int t = 0; t < nt; t += 2) {
            const bool last = (t == nt - 2);
            const char* a1 = cA + (size_t)(t + 1) * kstep;
            const char* a2 = last ? nA : cA + (size_t)(t + 2) * kstep; const char* b2 = last ? nB : cB + (size_t)(t + 2) * kstep;
            const char* a3 = a2 + kstep; const char* b3 = b2 + kstep;
            if (last && has_next) S.a_ready(nxt);
            if constexpr (SP2) {
            PG8_LDB(B0, 0, 0); PG8_LDB(B1, 0, 1); PG8_SCHED; PG8_LDA(At, 0, 0); PG8_STAGE(PG8_SA(1, 1), a1 + hstep, voffA);
            PG8_WAIT_V(8); PG8_WAIT_L(0); PG8_BAR; PG8_MMA(0, 0, At, B0); PG8_MMA(0, 1, At, B1); PG8_BAR; PG8_SCHED;
            PG8_LDA(At, 0, 1); PG8_STAGE(PG8_SB(0, 0), b2, voffB); PG8_STAGE(PG8_SB(0, 1), b2 + hstep, voffB); PG8_STAGE(PG8_SA(0, 0), a2, voffA);
            PG8_WAIT_V(8); PG8_WAIT_L(0); PG8_BAR; PG8_MMA(1, 0, At, B0); PG8_MMA(1, 1, At, B1); PG8_BAR; PG8_SCHED;
            PG8_LDB(B0, 1, 0); PG8_LDB(B1, 1, 1); PG8_SCHED; PG8_LDA(At, 1, 0); PG8_STAGE(PG8_SA(0, 1), a2 + hstep, voffA);
            PG8_WAIT_V(8); PG8_WAIT_L(0); PG8_BAR; PG8_MMA(0, 0, At, B0); PG8_MMA(0, 1, At, B1); PG8_BAR; PG8_SCHED;
            PG8_LDA(At, 1, 1); PG8_STAGE(PG8_SB(1, 0), b3, voffB); PG8_STAGE(PG8_SB(1, 1), b3 + hstep, voffB); PG8_STAGE(PG8_SA(1, 0), a3, voffA);
            PG8_WAIT_V(8); PG8_WAIT_L(0); PG8_BAR; PG8_MMA(1, 0, At, B0); PG8_MMA(1, 1, At, B1); PG8_BAR; PG8_SCHED;
            } else {
            PG8_LDB(B0, 0, 0); PG8_SCHED; PG8_LDA(At, 0, 0); PG8_STAGE(PG8_SA(1, 1), a1 + hstep, voffA);
            PG8_WAIT_L(8); PG8_BAR; PG8_WAIT_L(0); PG8_MMA(0, 0, At, B0); PG8_BAR; PG8_SCHED;
            PG8_LDB(B1, 0, 1); PG8_STAGE(PG8_SB(0, 0), b2, voffB);
            PG8_BAR; PG8_WAIT_L(0); PG8_MMA(0, 1, At, B1); PG8_BAR;
            PG8_LDA(At, 0, 1); PG8_STAGE(PG8_SA(0, 0), a2, voffA);
            PG8_BAR; PG8_WAIT_L(0); PG8_MMA(1, 0, At, B0); PG8_BAR; PG8_SCHED;
            PG8_STAGE(PG8_SB(0, 1), b2 + hstep, voffB);
            PG8_WAIT_V(6); PG8_BAR; PG8_MMA(1, 1, At, B1); PG8_BAR;
            PG8_LDB(B0, 1, 0); PG8_SCHED; PG8_LDA(At, 1, 0); PG8_STAGE(PG8_SA(0, 1), a2 + hstep, voffA);
            PG8_WAIT_L(8); PG8_BAR; PG8_WAIT_L(0); PG8_MMA(0, 0, At, B0); PG8_BAR; PG8_SCHED;
            PG8_LDB(B1, 1, 1); PG8_STAGE(PG8_SB(1, 0), b3, voffB);
            PG8_BAR; PG8_WAIT_L(0); PG8_MMA(0, 1, At, B1); PG8_BAR;
            PG8_LDA(At, 1, 1); PG8_STAGE(PG8_SA(1, 0), a3, voffA);
            PG8_BAR; PG8_WAIT_L(0); PG8_MMA(1, 0, At, B0); PG8_BAR; PG8_SCHED;
            PG8_STAGE(PG8_SB(1, 1), b3 + hstep, voffB);
            PG8_WAIT_V(6); PG8_BAR; PG8_MMA(1, 1, At, B1); PG8_BAR;
            }
        }
        if constexpr (ALIGN_EPI) { if (wr == 0) PG8_BAR; }
        E(acc, cur, wr, wc, fr, fq); S.done(cur);
        if (!has_next) break;
#pragma unroll
        for (int a = 0; a < 2; ++a)
#pragma unroll
            for (int b = 0; b < 2; ++b)
#pragma unroll
                for (int m = 0; m < 4; ++m)
#pragma unroll
                    for (int n = 0; n < 2; ++n) acc[a][b][m][n] = (f32x4){0.f, 0.f, 0.f, 0.f};
        cur = nxt; cA = nA; cB = nB; ++ui;
        if constexpr (ALIGN_EPI) { if (wr == 1) PG8_BAR; }
    }
    PG8_WAIT_V(0);
    if constexpr (!ALIGN_EPI) { if (wr == 0) PG8_BAR; }
    PG8_BAR;
#undef PG8_SA
#undef PG8_SB
#undef PG8_STAGE
#undef PG8_LDA
#undef PG8_LDB
#undef PG8_MMA
#undef PG8_WAIT_V
#undef PG8_WAIT_L
#undef PG8_BAR
#undef PG8_SCHED
}
}
using pg8::Unit;

struct EpiB {
    static constexpr bool PERM = true;
    bf16_t *Q, *F, *I, *ZB, *GB;
    __device__ __forceinline__ void operator()(const f32x4 (&acc)[2][2][4][2], const Unit& u, int wr, int wc, int fr, int fq) const {
        const int seg = u.pn >> 2;
        bf16_t* base = seg == 0 ? Q : seg == 1 ? F : seg == 2 ? I : seg == 3 ? ZB : GB;
        const int col0 = (u.pn & 3) * 256 + wc * 32 + 8 * fq, row0 = u.pm * 256 + wr * 64 + fr;
#pragma unroll
        for (int ai = 0; ai < 2; ++ai)
#pragma unroll
            for (int m = 0; m < 4; ++m) { bf16_t* rowp = base + (size_t)(row0 + ai * 128 + m * 16) * D + col0;
#pragma unroll
                for (int bj = 0; bj < 2; ++bj) { float v[8];
#pragma unroll
                    for (int j = 0; j < 4; ++j) { v[j] = acc[ai][bj][m][0][j]; v[4 + j] = acc[ai][bj][m][1][j]; }
                    u32x4 w;
                    if (seg == 1) { w.x = pk_f16(v[0], v[1]); w.y = pk_f16(v[2], v[3]); w.z = pk_f16(v[4], v[5]); w.w = pk_f16(v[6], v[7]); }
                    else {
                        if (seg == 0 || seg == 4) {
#pragma unroll
                            for (int j = 0; j < 8; ++j) { const float s = fsigmoid(v[j]); v[j] = (seg == 4) ? s : v[j] * s; } }
                        w.x = cvt_pk_bf16(v[0], v[1]); w.y = cvt_pk_bf16(v[2], v[3]); w.z = cvt_pk_bf16(v[4], v[5]); w.w = cvt_pk_bf16(v[6], v[7]); }
                    *(u32x4*)(rowp + bj * 128) = w; } }
    }
};
struct EpiA {
    static constexpr bool PERM = true;
    bf16_t *UZ, *V, *GA; float* stats;
    __device__ __forceinline__ void operator()(const f32x4 (&acc)[2][2][4][2], const Unit& u, int wr, int wc, int fr, int fq) const {
        const int row0 = u.pm * 256 + wr * 64 + fr;
        if (u.pn < 8) {
            const int col0 = u.pn * 128 + wc * 32 + 8 * fq;
#pragma unroll
            for (int ai = 0; ai < 2; ++ai)
#pragma unroll
                for (int m = 0; m < 4; ++m) { float v[8];
#pragma unroll
                    for (int j = 0; j < 4; ++j) { v[j] = fgelu_silu(acc[ai][0][m][0][j], acc[ai][1][m][0][j]); v[4 + j] = fgelu_silu(acc[ai][0][m][1][j], acc[ai][1][m][1][j]); }
                    u32x4 w; w.x = cvt_pk_bf16(v[0], v[1]); w.y = cvt_pk_bf16(v[2], v[3]); w.z = cvt_pk_bf16(v[4], v[5]); w.w = cvt_pk_bf16(v[6], v[7]);
                    *(u32x4*)(UZ + (size_t)(row0 + ai * 128 + m * 16) * D + col0) = w; }
        } else if (u.pn < 12) {
            const int pnl = u.pn - 8, col0 = pnl * 256 + wc * 32 + 8 * fq;
#pragma unroll
            for (int ai = 0; ai < 2; ++ai)
#pragma unroll
                for (int m = 0; m < 4; ++m) { const int row = row0 + ai * 128 + m * 16; float s = 0.f, ss = 0.f;
#pragma unroll
                    for (int bj = 0; bj < 2; ++bj) { float v[8];
#pragma unroll
                        for (int j = 0; j < 4; ++j) { v[j] = fgelu(acc[ai][bj][m][0][j]); v[4 + j] = fgelu(acc[ai][bj][m][1][j]); }
#pragma unroll
                        for (int j = 0; j < 8; ++j) { s += v[j]; ss += v[j] * v[j]; }
                        u32x4 w; w.x = cvt_pk_bf16(v[0], v[1]); w.y = cvt_pk_bf16(v[2], v[3]); w.z = cvt_pk_bf16(v[4], v[5]); w.w = cvt_pk_bf16(v[6], v[7]);
                        *(u32x4*)(V + (size_t)row * D + col0 + bj * 128) = w; }
                    s = xrow16_sum(s); ss = xrow16_sum(ss);
                    *(f32x2*)(stats + ((size_t)row * 16 + pnl * 4 + wc) * 2) = (f32x2){s, ss}; }
        } else {
            const int col0 = (u.pn - 12) * 256 + wc * 32 + 8 * fq;
#pragma unroll
            for (int ai = 0; ai < 2; ++ai)
#pragma unroll
                for (int m = 0; m < 4; ++m)
#pragma unroll
                    for (int bj = 0; bj < 2; ++bj) { float v[8];
#pragma unroll
                        for (int j = 0; j < 4; ++j) { v[j] = fsigmoid(acc[ai][bj][m][0][j]); v[4 + j] = fsigmoid(acc[ai][bj][m][1][j]); }
                        u32x4 w; w.x = cvt_pk_bf16(v[0], v[1]); w.y = cvt_pk_bf16(v[2], v[3]); w.z = cvt_pk_bf16(v[4], v[5]); w.w = cvt_pk_bf16(v[6], v[7]);
                        *(u32x4*)(GA + (size_t)(row0 + ai * 128 + m * 16) * D + col0 + bj * 128) = w; }
        }
    }
};
template <bool ADD> struct EpiGate {
    static constexpr bool PERM = true;
    const bf16_t* G; const bf16_t* T; bf16_t* O;
    __device__ __forceinline__ void operator()(const f32x4 (&acc)[2][2][4][2], const Unit& u, int wr, int wc, int fr, int fq) const {
        const int col0 = u.pn * 256 + wc * 32 + 8 * fq, row0 = u.pm * 256 + wr * 64 + fr;
#pragma unroll
        for (int ai = 0; ai < 2; ++ai)
#pragma unroll
            for (int m = 0; m < 4; ++m) { const size_t off = (size_t)(row0 + ai * 128 + m * 16) * D + col0;
#pragma unroll
                for (int bj = 0; bj < 2; ++bj) { const u32x4 gq = *(const u32x4*)(G + off + bj * 128);
                    const unsigned gw[4] = {gq.x, gq.y, gq.z, gq.w}; float v[8];
#pragma unroll
                    for (int j = 0; j < 2; ++j) { v[2 * j] = bf_lo(gw[j]) * acc[ai][bj][m][0][2 * j]; v[2 * j + 1] = bf_hi(gw[j]) * acc[ai][bj][m][0][2 * j + 1];
                        v[4 + 2 * j] = bf_lo(gw[2 + j]) * acc[ai][bj][m][1][2 * j]; v[5 + 2 * j] = bf_hi(gw[2 + j]) * acc[ai][bj][m][1][2 * j + 1]; }
                    if (ADD) { const u32x4 tq = *(const u32x4*)(T + off + bj * 128); const unsigned tw[4] = {tq.x, tq.y, tq.z, tq.w};
#pragma unroll
                        for (int j = 0; j < 4; ++j) { v[2 * j] += bf_lo(tw[j]); v[2 * j + 1] += bf_hi(tw[j]); } }
                    u32x4 w; w.x = cvt_pk_bf16(v[0], v[1]); w.y = cvt_pk_bf16(v[2], v[3]); w.z = cvt_pk_bf16(v[4], v[5]); w.w = cvt_pk_bf16(v[6], v[7]);
                    *(u32x4*)(O + off + bj * 128) = w; } }
    }
};
struct EpiO {
    static constexpr bool PERM = false;
    const float *xp, *xs; float* xo; const float* mod;
    __device__ __forceinline__ void operator()(const f32x4 (&acc)[2][2][4][2], const Unit& u, int wr, int wc, int fr, int fq) const {
        const unsigned col0 = (unsigned)(u.pn * 256 + wc * 32 + 4 * fq);
        const float* xt = ((u.pm < MP / 256) ? xp : xs - (size_t)MP * D) + (size_t)u.pm * 256 * D;
        float* ot = xo + (size_t)u.pm * 256 * D;
#pragma unroll
        for (int ai = 0; ai < 2; ++ai) {
            const int ci = cond_of_row(u.pm * 256 + ai * 128 + wr * 64);
            const float* gate = mod + (size_t)ci * 3 * D + 2 * D;
            f32x4 gv[2][2];
#pragma unroll
            for (int bj = 0; bj < 2; ++bj)
#pragma unroll
                for (int n = 0; n < 2; ++n) gv[bj][n] = *(const f32x4*)(gate + (col0 + bj * 128 + n * 16));
#pragma unroll
            for (int m = 0; m < 4; ++m) { const unsigned off = (unsigned)(ai * 128 + wr * 64 + m * 16 + fr) * D + col0;
#pragma unroll
                for (int bj = 0; bj < 2; ++bj)
#pragma unroll
                    for (int n = 0; n < 2; ++n) { const f32x4 xv = *(const f32x4*)(xt + (off + bj * 128 + n * 16));
                        *(f32x4*)(ot + (off + bj * 128 + n * 16)) = xv + gv[bj][n] * acc[ai][bj][m][n]; }
                asm volatile("" ::: "memory"); } }
    }
};


__device__ __forceinline__ int win_src_col(int n) {
    if (n < 4096) return 3072 + n;
    if (n < 5120) return 8192 + (n - 4096);
    n -= 5120;
    if (n < 2048) { const int t = n >> 8, r = n & 255; return r < 128 ? 128 * t + r : 2048 + 128 * t + (r - 128); }
    if (n < 3072) return 1024 + (n - 2048);
    return 7168 + (n - 3072);
}
__device__ __forceinline__ void transpose_item(const float* W, int ldn, int n0s, int k0, bf16_t* WT, int n0d, LAS float* scr, int lane) {
#pragma unroll 8
    for (int i = 0; i < 32; ++i) { const int kk = 2 * i + (lane >> 5); scr[kk * 33 + (lane & 31)] = W[(size_t)(k0 + kk) * ldn + n0s + (lane & 31)]; }
    __builtin_amdgcn_s_waitcnt(0xc07f); asm volatile("" ::: "memory");
    const int c = lane & 7;
#pragma unroll
    for (int j = 0; j < 4; ++j) { const int n = (lane >> 3) + 8 * j; const LAS float* s = scr + (8 * c) * 33 + n;
        u32x4 o; o.x = cvt_pk_bf16(s[0 * 33], s[1 * 33]); o.y = cvt_pk_bf16(s[2 * 33], s[3 * 33]); o.z = cvt_pk_bf16(s[4 * 33], s[5 * 33]); o.w = cvt_pk_bf16(s[6 * 33], s[7 * 33]);
        *(u32x4*)(WT + (size_t)(n0d + n) * D + k0 + 8 * c) = o; }
    __builtin_amdgcn_s_waitcnt(0xc07f); asm volatile("" ::: "memory");
}
__device__ __forceinline__ void phase_prep(CParams* p, LAS unsigned char* lds) {
    const int tid = otid(), lane = tid & 63, wave = tid >> 6, G = ogrid(), bid = obid();
    {
        LAS float* sc = (LAS float*)lds;
        LAS float* part = sc + 8192;
        for (int it = bid; it < 576; it += G) {
            const int l = it / 288, rg = (it % 288) / 48, cb = it % 48;
            __syncthreads();
            for (int e = tid; e < 8 * 1024; e += 512) { const int r = e >> 10, k = e & 1023, ci = rg * 8 + r;
                const float cv = ci < 16 ? p->c_prompt[(size_t)ci * D + k] : p->c_sample[(size_t)(ci - 16) * D + k]; sc[k * 8 + r] = fsilu(cv); }
            __syncthreads();
            const int col = cb * 64 + lane; const float* w = p->w_ada + (size_t)l * D * 3 * D + (size_t)(wave * 128) * 3 * D + col;
            float a[8] = {0.f, 0.f, 0.f, 0.f, 0.f, 0.f, 0.f, 0.f};
            for (int k8 = 0; k8 < 128; k8 += 8) { float wv[8];
#pragma unroll
                for (int u = 0; u < 8; ++u) wv[u] = w[(size_t)(k8 + u) * 3 * D];
#pragma unroll
                for (int u = 0; u < 8; ++u) { const LAS float* s = sc + (wave * 128 + k8 + u) * 8; const f32x4 s0 = *(const LAS f32x4*)s, s1 = *(const LAS f32x4*)(s + 4);
                    a[0] += s0.x * wv[u]; a[1] += s0.y * wv[u]; a[2] += s0.z * wv[u]; a[3] += s0.w * wv[u]; a[4] += s1.x * wv[u]; a[5] += s1.y * wv[u]; a[6] += s1.z * wv[u]; a[7] += s1.w * wv[u]; } }
#pragma unroll
            for (int r = 0; r < 8; ++r) part[(wave * 8 + r) * 64 + lane] = a[r];
            __syncthreads();
            { float s = 0.f;
#pragma unroll
              for (int w2 = 0; w2 < 8; ++w2) s += part[(w2 * 8 + wave) * 64 + lane];
              ((float*)(p->ws + WS_MOD))[((size_t)l * NCOND + rg * 8 + wave) * 3 * D + col] = s + p->b_ada[(size_t)l * 3 * D + col]; }
        }
        __syncthreads();
    }
    {
        LAS float* scr = (LAS float*)(lds + wave * 8704);
        const int gw = bid * 8 + wave, NGW = G * 8;
        constexpr int I_IN = 16 * (NIN / 32), I_SQ = 16 * (D / 32), PER_L = I_IN + 3 * I_SQ;
        for (int it = gw; it < 2 * PER_L; it += NGW) { const int l = it / PER_L; int r = it % PER_L;
            if (r < I_IN) { const int kb = r / (NIN / 32), nb = r % (NIN / 32);
                transpose_item(p->w_in + (size_t)l * D * NIN, NIN, win_src_col(nb * 32), kb * 64, (bf16_t*)(p->ws + WS_WIN) + (size_t)l * NIN * D, nb * 32, scr, lane); continue; }
            r -= I_IN; const int which = r / I_SQ; r %= I_SQ; const int kb = r / (D / 32), nb = r % (D / 32);
            const float* src = (which == 0 ? p->w_pa : which == 1 ? p->w_pb : p->w_o) + (size_t)l * D * D;
            bf16_t* dst = (bf16_t*)(p->ws + (which == 0 ? WS_WPA : which == 1 ? WS_WPB : WS_WO)) + (size_t)l * D * D;
            transpose_item(src, D, nb * 32, kb * 64, dst, nb * 32, scr, lane); }
    }
}

__device__ __forceinline__ void phase_norm(CParams* p, int l, const float* xp, const float* xs, bf16_t* H) {
    const int tid = otid(), lane = tid & 63, gw = obid() * 8 + (tid >> 6), NGW = ogrid() * 8;
    const float* g = p->norm_g + (size_t)l * D; const float* mod = (const float*)(p->ws + WS_MOD) + (size_t)l * NCOND * 3 * D;
    for (int row = gw; row < M; row += NGW) {
        const float* xr = row < MP ? xp + (size_t)row * D : xs + (size_t)(row - MP) * D;
        const float* mrow = mod + (size_t)cond_of_row(row) * 3 * D;
        f32x4 v[4]; float s = 0.f;
#pragma unroll
        for (int j = 0; j < 4; ++j) { v[j] = *(const f32x4*)(xr + 4 * lane + 256 * j); s += (v[j].x * v[j].x + v[j].y * v[j].y) + (v[j].z * v[j].z + v[j].w * v[j].w); }
        const float r = rsqrtf(wave_sum(s) * (1.f / D) + EPS);
#pragma unroll
        for (int j = 0; j < 4; ++j) { const int c = 4 * lane + 256 * j; const f32x4 gv = *(const f32x4*)(g + c), sh = *(const f32x4*)(mrow + c), sc = *(const f32x4*)(mrow + D + c);
            const f32x4 h = (v[j] * r) * gv * (sc + 1.0f) + sh;
            u32x2 w; w.x = cvt_pk_bf16(h.x, h.y); w.y = cvt_pk_bf16(h.z, h.w); *(u32x2*)(H + (size_t)row * D + c) = w; }
    }
}
__device__ __forceinline__ void phase_final(CParams* p) {
    const int tid = otid(), lane = tid & 63, gw = obid() * 8 + (tid >> 6), NGW = ogrid() * 8;
    for (int row = gw; row < M; row += NGW) {
        float* xr = p->out + OUT_Y + (size_t)row * D;
        f32x4 v[4]; float s = 0.f;
#pragma unroll
        for (int j = 0; j < 4; ++j) { v[j] = *(const f32x4*)(xr + 4 * lane + 256 * j); s += (v[j].x * v[j].x + v[j].y * v[j].y) + (v[j].z * v[j].z + v[j].w * v[j].w); }
        const float r = rsqrtf(wave_sum(s) * (1.f / D) + EPS);
#pragma unroll
        for (int j = 0; j < 4; ++j) { const int c = 4 * lane + 256 * j; const f32x4 gv = *(const f32x4*)(p->final_g + c); *(f32x4*)(xr + c) = (v[j] * r) * gv; }
    }
}

__device__ __forceinline__ void phase_scan(CParams* p, int l, const bf16_t* Q, const bf16_t* F, bf16_t* I, float* SQ, LAS unsigned char* lds) {
    const int tid = otid(), G = ogrid(), bid = obid();
    LAS float* fS = (LAS float*)lds; LAS float* kS = fS + 2048; LAS float* qS = kS + 2048; LAS float* iS = qS + 2048; LAS float* op = iS + 2048;
    const int lane = tid & 63, kg = lane & 15, vg = (tid >> 6) * 4 + (lane >> 4), k0 = kg * 8;
    const int st = tid >> 5, sc4 = (tid & 31) * 4, vl2 = (tid & 31) * 2;
    for (int it = bid; it < 768; it += G) {
        const bool prompt = it < 256; const int id = prompt ? it : it - 256, b = id >> 4, h = (id >> 1) & 7, vh = id & 1;
        const int T = prompt ? 2048 : 64, row0 = prompt ? b * 2048 : MP + b * 64, v0 = vh * 64 + vg * 2;
        float* sout = p->out + (prompt ? OUT_SP + ((size_t)(l * 16 + b) * 8 + h) * 16384 : OUT_SS + ((size_t)(l * 32 + b) * 8 + h) * 16384);
        f32x2 S[8];
        if (prompt) {
#pragma unroll
            for (int j = 0; j < 8; ++j) S[j] = (f32x2){0.f, 0.f};
        } else { const float* sin = p->state_hgrn + ((size_t)(l * 32 + b) * 8 + h) * 16384;
#pragma unroll
            for (int j = 0; j < 8; ++j) S[j] = *(const f32x2*)(sin + (k0 + j) * 128 + v0); }
        float lb[4];
#pragma unroll
        for (int j = 0; j < 4; ++j) { const int hk = h * 128 + sc4 + j; lb[j] = l == 0 ? 0.f : fsigmoid(p->lb_raw[D + hk] - p->lb_raw[hk]); }
        const size_t off0 = (size_t)(row0 + st) * D + h * 128 + sc4;
        u32x2 qw = *(const u32x2*)(Q + off0), fw = *(const u32x2*)(F + off0), iw = *(const u32x2*)(I + off0);
        auto stage = [&](int tnext) {
            *(LAS f32x4*)(qS + st * 128 + sc4) = (f32x4){bf_lo(qw.x), bf_hi(qw.x), bf_lo(qw.y), bf_hi(qw.y)};
            *(LAS f32x4*)(iS + st * 128 + sc4) = (f32x4){bf_lo(iw.x), bf_hi(iw.x), bf_lo(iw.y), bf_hi(iw.y)};
            const float z[4] = {f16_lo(fw.x), f16_hi(fw.x), f16_lo(fw.y), f16_hi(fw.y)}; f32x4 fv;
#pragma unroll
            for (int j = 0; j < 4; ++j) { const float sg = fsigmoid(z[j]); fv[j] = lb[j] + (1.f - lb[j]) * sg; }
            *(LAS f32x4*)(fS + st * 128 + sc4) = fv;
            if (tnext < T) { const size_t off = off0 + (size_t)tnext * D; qw = *(const u32x2*)(Q + off); fw = *(const u32x2*)(F + off); iw = *(const u32x2*)(I + off); }
        };
        __syncthreads();
        stage(16);
        for (int t0 = 0; t0 < T; t0 += 16) {
            __syncthreads();
            {
                f32x2 iv = *(const LAS f32x2*)(iS + v0);
                f32x4 fa = *(const LAS f32x4*)(fS + k0), fb = *(const LAS f32x4*)(fS + k0 + 4);
                f32x4 qa = *(const LAS f32x4*)(qS + k0), qb = *(const LAS f32x4*)(qS + k0 + 4);
                f32x2 oacc[16];
#pragma unroll
                for (int t = 0; t < 16; ++t) {
                    const int tn = (t + 1 < 16) ? t + 1 : t;
                    const f32x2 ivn = *(const LAS f32x2*)(iS + tn * 128 + v0);
                    const f32x4 fan = *(const LAS f32x4*)(fS + tn * 128 + k0), fbn = *(const LAS f32x4*)(fS + tn * 128 + k0 + 4);
                    const f32x4 qan = *(const LAS f32x4*)(qS + tn * 128 + k0), qbn = *(const LAS f32x4*)(qS + tn * 128 + k0 + 4);
                    f32x2 o = (f32x2){0.f, 0.f};
#pragma unroll
                    for (int j = 0; j < 4; ++j) { S[j] = (S[j] - iv) * fa[j] + iv; o += S[j] * qa[j]; S[4 + j] = (S[4 + j] - iv) * fb[j] + iv; o += S[4 + j] * qb[j]; }
                    oacc[t] = o;
                    iv = ivn; fa = fan; fb = fbn; qa = qan; qb = qbn;
                }
                const bool b0 = (kg & 1) != 0, b1 = (kg & 2) != 0, b2 = (kg & 4) != 0, b3 = (kg & 8) != 0;
                f32x2 a8[8], a4[4], a2[2];
#pragma unroll
                for (int j = 0; j < 8; ++j) { const f32x2 keep = b0 ? oacc[8 + j] : oacc[j], send = b0 ? oacc[j] : oacc[8 + j];
                    a8[j].x = keep.x + dpp_mov<0xB1>(send.x); a8[j].y = keep.y + dpp_mov<0xB1>(send.y); }
#pragma unroll
                for (int j = 0; j < 4; ++j) { const f32x2 keep = b1 ? a8[4 + j] : a8[j], send = b1 ? a8[j] : a8[4 + j];
                    a4[j].x = keep.x + dpp_mov<0x4E>(send.x); a4[j].y = keep.y + dpp_mov<0x4E>(send.y); }
#pragma unroll
                for (int j = 0; j < 2; ++j) { const f32x2 keep = b3 ? a4[2 + j] : a4[j], send = b3 ? a4[j] : a4[2 + j];
                    a2[j].x = keep.x + dpp_mov<0x128>(send.x); a2[j].y = keep.y + dpp_mov<0x128>(send.y); }
                { const f32x2 keep = b2 ? a2[1] : a2[0], send = b2 ? a2[0] : a2[1]; f32x2 r;
                  r.x = keep.x + dpp_mov<0x1B>(dpp_mov<0x141>(send.x)); r.y = keep.y + dpp_mov<0x1B>(dpp_mov<0x141>(send.y));
                  const int tok = (b0 ? 8 : 0) + (b1 ? 4 : 0) + (b3 ? 2 : 0) + (b2 ? 1 : 0);
                  *(LAS f32x2*)(op + tok * 64 + vg * 2) = r; }
            }
            __syncthreads();
            { const f32x2 o = *(const LAS f32x2*)(op + st * 64 + vl2); float ss = o.x * o.x + o.y * o.y;
#pragma unroll
              for (int w = 1; w < 32; w <<= 1) ss += __shfl_xor(ss, w);
              const int row = row0 + t0 + st;
              if ((tid & 31) == 0) SQ[((size_t)row * 8 + h) * 2 + vh] = ss;
              *(unsigned*)(I + (size_t)row * D + h * 128 + vh * 64 + vl2) = cvt_pk_bf16(o.x, o.y); }
            if (t0 + 16 < T) stage(t0 + 32);
        }
#pragma unroll
        for (int j = 0; j < 8; ++j) *(f32x2*)(sout + (k0 + j) * 128 + v0) = S[j];
    }
}
__device__ __forceinline__ void phase_hnorm(CParams* p, int l, const bf16_t* O, bf16_t* Q, const bf16_t* ZB, const float* SQ) {
    const int tid = otid(), G = ogrid(), bid = obid();
    const float* gnp = p->gnorm_g + (size_t)l * D;
    for (int idx = bid * 512 + tid; idx < M * 128; idx += G * 512) {
        const int row = idx >> 7, c8 = (idx & 127) * 8, h = c8 >> 7;
        const f32x2 sq = *(const f32x2*)(SQ + ((size_t)row * 8 + h) * 2);
        const float r = rsqrtf((sq.x + sq.y) * (1.f / 128.f) + EPS);
        const u32x4 ow = *(const u32x4*)(O + (size_t)row * D + c8), zw = *(const u32x4*)(ZB + (size_t)row * D + c8);
        const f32x4 g0 = *(const f32x4*)(gnp + c8), g1 = *(const f32x4*)(gnp + c8 + 4);
        const unsigned oa[4] = {ow.x, ow.y, ow.z, ow.w}, za[4] = {zw.x, zw.y, zw.z, zw.w}; const float ga[8] = {g0.x, g0.y, g0.z, g0.w, g1.x, g1.y, g1.z, g1.w};
        u32x4 w; unsigned wa[4];
#pragma unroll
        for (int j = 0; j < 4; ++j) wa[j] = cvt_pk_bf16((bf_lo(oa[j]) * r) * ga[2 * j] * fsilu(bf_lo(za[j])), (bf_hi(oa[j]) * r) * ga[2 * j + 1] * fsilu(bf_hi(za[j])));
        w.x = wa[0]; w.y = wa[1]; w.z = wa[2]; w.w = wa[3];
        *(u32x4*)(Q + (size_t)row * D + c8) = w;
    }
}

__device__ __forceinline__ void phase_gmlp(CParams* p, int l, bf16_t* UZ, const bf16_t* V, LAS unsigned char* lds) {
    const int tid = otid(), G = ogrid(), bid = obid();
    constexpr int STR = 272;
    LAS unsigned char* vnT = lds;
    LAS unsigned char* Wb = lds + 256 * STR;
    LAS float* rs = (LAS float*)(lds + 384 * STR);
    const float* stats = (const float*)(p->ws + WS_STATS);
    const int lane = tid & 63, wave = tid >> 6, fr = lane & 15, fq = lane >> 4;
    int g_staged = -1;
    for (int it = bid; it < 288 * 4; it += G) {
        const int cix = it >> 2, g = it & 3, cb = g * 256;
        const bool prompt = cix < 256; const int R = prompt ? 128 : 64, row0 = prompt ? cix * 128 : MP + (cix - 256) * 64;
        __syncthreads();
        u32x4 vq[8];
#pragma unroll
        for (int i = 0; i < 8; ++i) { const int u = tid + 512 * i;
            if (u < R * 32) { const int s = prompt ? (u & 127) : (u & 63), c8 = (prompt ? (u >> 7) : (u >> 6)) * 8; vq[i] = *(const u32x4*)(V + (size_t)(row0 + s) * D + cb + c8); } }
        if (tid < R) { const float* sp = stats + (size_t)(row0 + tid) * 32; float s = 0.f, ss = 0.f;
#pragma unroll
            for (int j = 0; j < 16; ++j) { const f32x2 a2 = *(const f32x2*)(sp + 2 * j); s += a2.x; ss += a2.y; }
            const float mu = s * (1.f / D), var = fmaxf(ss * (1.f / D) - mu * mu, 0.f); rs[2 * tid] = mu; rs[2 * tid + 1] = rsqrtf(var + EPS); }
        if (g != g_staged) { g_staged = g; const float* wsrc = p->w_s + (size_t)(l * 4 + g) * 16384;
#pragma unroll
          for (int i = 0; i < 8; ++i) { const int u = tid + 512 * i, t = u >> 5, s4 = (u & 31) * 4; f32x4 w4 = *(const f32x4*)(wsrc + t * 128 + s4);
              w4.x = (s4 + 0 <= t) ? w4.x : 0.f; w4.y = (s4 + 1 <= t) ? w4.y : 0.f; w4.z = (s4 + 2 <= t) ? w4.z : 0.f; w4.w = (s4 + 3 <= t) ? w4.w : 0.f;
              u32x2 q; q.x = cvt_pk_bf16(w4.x, w4.y); q.y = cvt_pk_bf16(w4.z, w4.w); *(LAS u32x2*)(Wb + t * STR + s4 * 2) = q; } }
        __syncthreads();
#pragma unroll
        for (int i = 0; i < 8; ++i) { const int u = tid + 512 * i;
            if (u < R * 32) { const int s = prompt ? (u & 127) : (u & 63), c8 = (prompt ? (u >> 7) : (u >> 6)) * 8;
            const u32x4 q = vq[i]; const float mu = rs[2 * s], rstd = rs[2 * s + 1];
            const float* lg = p->ln_v_g + (size_t)l * D + cb + c8; const float* lbp = p->ln_v_b + (size_t)l * D + cb + c8;
            const f32x4 g0 = *(const f32x4*)lg, g1 = *(const f32x4*)(lg + 4), b0 = *(const f32x4*)lbp, b1 = *(const f32x4*)(lbp + 4);
            f32x4 x0 = (f32x4){bf_lo(q.x), bf_hi(q.x), bf_lo(q.y), bf_hi(q.y)}, x1 = (f32x4){bf_lo(q.z), bf_hi(q.z), bf_lo(q.w), bf_hi(q.w)};
            x0 = (x0 - mu) * rstd * g0 + b0; x1 = (x1 - mu) * rstd * g1 + b1;
            const unsigned pa = cvt_pk_bf16(x0.x, x0.y), pb = cvt_pk_bf16(x0.z, x0.w), pc = cvt_pk_bf16(x1.x, x1.y), pd = cvt_pk_bf16(x1.z, x1.w);
            LAS unsigned short* dst = (LAS unsigned short*)(vnT + c8 * STR + s * 2);
            dst[0] = (unsigned short)(pa & 0xffffu); dst[STR / 2] = (unsigned short)(pa >> 16); dst[2 * (STR / 2)] = (unsigned short)(pb & 0xffffu); dst[3 * (STR / 2)] = (unsigned short)(pb >> 16);
            dst[4 * (STR / 2)] = (unsigned short)(pc & 0xffffu); dst[5 * (STR / 2)] = (unsigned short)(pc >> 16); dst[6 * (STR / 2)] = (unsigned short)(pd & 0xffffu); dst[7 * (STR / 2)] = (unsigned short)(pd >> 16);
            if (!prompt) { float* vo = p->out + OUT_VS + ((size_t)(l * 32 + (cix - 256)) * 64 + s) * D + cb + c8; *(f32x4*)vo = x0; *(f32x4*)(vo + 4) = x1; } } }
        const int t0 = wave * 16, t = t0 + fr;
        bf16_t* urow = UZ + (size_t)(row0 + t) * D + cb + 4 * fq;
        u32x2 uzr[16]; float bias = 0.f;
        if (t0 < R) { bias = p->b_s[(size_t)(l * 4 + g) * 128 + t];
#pragma unroll
            for (int c = 0; c < 16; ++c) uzr[c] = *(const u32x2*)(urow + c * 16); }
        __syncthreads();
        if (t0 < R) {
            f32x4 acc[16];
#pragma unroll
            for (int c = 0; c < 16; ++c) acc[c] = (f32x4){0.f, 0.f, 0.f, 0.f};
            const int nsteps = (t0 + 15) / 32 + 1;
            for (int ks = 0; ks < nsteps; ++ks) { const int soff = (32 * ks + 8 * fq) * 2;
                const bf16x8 Bf = *(const LAS bf16x8*)(Wb + (t0 + fr) * STR + soff);
#pragma unroll
                for (int c = 0; c < 16; ++c) { const bf16x8 Af = *(const LAS bf16x8*)(vnT + (c * 16 + fr) * STR + soff); acc[c] = __builtin_amdgcn_mfma_f32_16x16x32_bf16(Af, Bf, acc[c], 0, 0, 0); } }
#pragma unroll
            for (int c = 0; c < 16; ++c) { const u32x2 uz = uzr[c];
                u32x2 w; w.x = cvt_pk_bf16(bf_lo(uz.x) * (acc[c].x + bias), bf_hi(uz.x) * (acc[c].y + bias)); w.y = cvt_pk_bf16(bf_lo(uz.y) * (acc[c].z + bias), bf_hi(uz.y) * (acc[c].w + bias));
                *(u32x2*)(urow + c * 16) = w; }
        }
    }
}

__device__ __forceinline__ void grid_barrier(unsigned* ctr, unsigned target) {
    asm volatile("s_waitcnt vmcnt(0)" ::: "memory");
    __syncthreads();
    if (threadIdx.x == 0) {
        __builtin_amdgcn_fence(__ATOMIC_RELEASE, "agent");
        asm volatile("s_waitcnt vmcnt(0)" ::: "memory");
        (void)__hip_atomic_fetch_add(ctr, 1u, __ATOMIC_RELAXED, __HIP_MEMORY_SCOPE_AGENT);
        unsigned sp = 0u;
        while (__hip_atomic_load(ctr, __ATOMIC_RELAXED, __HIP_MEMORY_SCOPE_AGENT) < target) { __builtin_amdgcn_s_sleep(1); if (++sp > (1u << 22)) break; }
        __builtin_amdgcn_fence(__ATOMIC_ACQUIRE, "agent");
        asm volatile("s_waitcnt vmcnt(0)" ::: "memory");
    }
    __syncthreads();
}

__global__ void __launch_bounds__(512) fwd_kernel(Params p_arg) {
    extern __shared__ __attribute__((aligned(16))) unsigned char shm[];
    LAS unsigned char* lds = (LAS unsigned char*)shm;
    const int ph_lo = p_arg.ph_lo, ph_hi = p_arg.ph_hi;
    for (int ph = ph_lo; ph < ph_hi; ++ph) {
        CParams* p = (CParams*)__builtin_amdgcn_kernarg_segment_ptr(); asm volatile("" : "+s"(p));
        unsigned char* ws = p->ws;
        bf16_t* B0 = (bf16_t*)(ws + WS_BUF); bf16_t* B1 = B0 + (size_t)M * D; bf16_t* B2 = B1 + (size_t)M * D; bf16_t* B3 = B2 + (size_t)M * D; bf16_t* B4 = B3 + (size_t)M * D; bf16_t* B5 = B4 + (size_t)M * D;
        float* xbuf = p->out + OUT_Y;
        const int G = ogrid(), bid = obid();
        if (ph == 0) { if (bid == 0 && threadIdx.x == 0) __hip_atomic_store((unsigned*)(ws + WS_BAR), 0u, __ATOMIC_RELAXED, __HIP_MEMORY_SCOPE_AGENT); phase_prep(p, lds); }
        else if (ph == 19) phase_final(p);
        else {
            const int l = (ph - 1) / 9, sub = (ph - 1) % 9;
            const float* xp = l == 0 ? p->x_prompt : xbuf; const float* xs = l == 0 ? p->x_sample : xbuf + (size_t)MP * D;
            const bf16_t* WinT = (const bf16_t*)(ws + WS_WIN) + (size_t)l * NIN * D;
            pg8::StaticOrder S;
            if (sub == 0) phase_norm(p, l, xp, xs, B0);
            else if (sub == 1) { pg8::Gemm g{B0, WinT, M, NB_COLS, D}; S.init(M, NB_COLS, G, bid); EpiB E{B1, B2, B3, B5, B4};
                pg8::gemm_phase<EpiB, pg8::StaticOrder, true, true>(lds, g, S, E); }
            else if (sub == 2) phase_scan(p, l, B1, B2, B3, (float*)(ws + WS_STATS), lds);
            else if (sub == 3) phase_hnorm(p, l, B3, B1, B5, (const float*)(ws + WS_STATS));
            else if (sub == 4) { pg8::Gemm g{B1, (const bf16_t*)(ws + WS_WPB) + (size_t)l * D * D, M, D, D}; S.init(M, D, G, bid); EpiGate<false> E{B4, nullptr, B2};
                pg8::gemm_phase<EpiGate<false>, pg8::StaticOrder, true, true>(lds, g, S, E); }
            else if (sub == 5) { pg8::Gemm g{B0, WinT + (size_t)NB_COLS * D, M, NA_COLS, D}; S.init(M, NA_COLS, G, bid); EpiA E{B3, B5, B4, (float*)(ws + WS_STATS)};
                pg8::gemm_phase<EpiA, pg8::StaticOrder, true, true>(lds, g, S, E); }
            else if (sub == 6) phase_gmlp(p, l, B3, B5, lds);
            else if (sub == 7) { pg8::Gemm g{B3, (const bf16_t*)(ws + WS_WPA) + (size_t)l * D * D, M, D, D}; S.init(M, D, G, bid); EpiGate<true> E{B4, B2, B5};
                pg8::gemm_phase<EpiGate<true>, pg8::StaticOrder, true, true>(lds, g, S, E); }
            else { pg8::Gemm g{B5, (const bf16_t*)(ws + WS_WO) + (size_t)l * D * D, M, D, D}; S.init(M, D, G, bid);
                EpiO E{xp, xs, xbuf, (const float*)(ws + WS_MOD) + (size_t)l * NCOND * 3 * D};
                pg8::gemm_phase<EpiO, pg8::StaticOrder, true, true>(lds, g, S, E); }
        }
#if MK_ONE_LAUNCH
        if (ph + 1 < ph_hi) { if (ph == 0) cg::this_grid().sync(); else grid_barrier((unsigned*)(ws + WS_BAR), (unsigned)ph * (unsigned)G); }
#endif
    }
}


extern "C" void kernel_launch(void* const* d_in, const int* in_sizes, int n_in, void* d_out, int out_size, void* d_ws, size_t ws_size, hipStream_t stream) {
    static int grid = 0;
    if (grid == 0) {
        if (n_in != 19 || ws_size < WS_END) { fprintf(stderr, "kernel_launch: need 19 inputs and %zu bytes of workspace; got %d, %zu\n", (size_t)WS_END, n_in, ws_size); grid = -1; return; }
        if (hipFuncSetAttribute((const void*)fwd_kernel, hipFuncAttributeMaxDynamicSharedMemorySize, LDS_BYTES) != hipSuccess) { fprintf(stderr, "kernel_launch: hipFuncSetAttribute failed\n"); grid = -1; return; }
        int dev = 0, cus = 0, per_cu = 0;
        hipGetDevice(&dev); hipDeviceGetAttribute(&cus, hipDeviceAttributeMultiprocessorCount, dev);
        hipOccupancyMaxActiveBlocksPerMultiprocessor(&per_cu, (const void*)fwd_kernel, 512, LDS_BYTES);
        if (per_cu < 1) { fprintf(stderr, "kernel_launch: occupancy query says %d blocks per CU\n", per_cu); per_cu = 1; }
        (void)hipGetLastError();
        grid = cus;
    }
    if (grid < 0) return;
    Params p{};
    const float** pp = (const float**)&p;
    for (int i = 0; i < 19; ++i) pp[i] = (const float*)d_in[i];
    p.out = (float*)d_out; p.ws = (unsigned char*)d_ws;
#if MK_ONE_LAUNCH
    p.ph_lo = 0; p.ph_hi = 20;
    void* args[] = {&p};
    hipError_t e = hipLaunchCooperativeKernel((const void*)fwd_kernel, dim3(grid), dim3(512), args, LDS_BYTES, stream);
    if (e != hipSuccess) fprintf(stderr, "cooperative launch failed: %s (grid %d)\n", hipGetErrorString(e), grid);
#else
    for (int ph = 0; ph < 20; ++ph) { p.ph_lo = ph; p.ph_hi = ph + 1; hipLaunchKernelGGL(fwd_kernel, dim3(grid), dim3(512), LDS_BYTES, stream, p); }
#endif
}
```

```cpp
#include <hip/hip_runtime.h>
#include <hip/hip_cooperative_groups.h>
#include <cstdio>
#include <cstdint>
namespace cg = cooperative_groups;

#ifndef MK_ONE_LAUNCH
#define MK_ONE_LAUNCH 1
#endif

#define LAS __attribute__((address_space(3)))
typedef unsigned short bf16_t;
typedef short bf16x8 __attribute__((ext_vector_type(8)));
typedef float f32x4 __attribute__((ext_vector_type(4)));
typedef float f32x2 __attribute__((ext_vector_type(2)));
typedef unsigned u32x4 __attribute__((ext_vector_type(4)));
typedef unsigned u32x2 __attribute__((ext_vector_type(2)));
typedef _Float16 f16x2 __attribute__((ext_vector_type(2)));

constexpr int D = 1024, MP = 32768, MS = 2048, M = MP + MS, NCOND = 48, NIN = 9216;
constexpr int NB_COLS = 5120, NA_COLS = 4096;
constexpr float EPS = 1e-6f;
constexpr size_t OUT_Y = 0, OUT_SP = (size_t)M * D, OUT_SS = OUT_SP + (size_t)2 * 16 * 8 * 16384, OUT_VS = OUT_SS + (size_t)2 * 32 * 8 * 16384;
constexpr size_t BUF_BYTES = (size_t)M * D * 2;
constexpr size_t WS_WIN = 0;
constexpr size_t WS_WPA = WS_WIN + (size_t)2 * NIN * D * 2;
constexpr size_t WS_WPB = WS_WPA + (size_t)2 * D * D * 2;
constexpr size_t WS_WO = WS_WPB + (size_t)2 * D * D * 2;
constexpr size_t WS_MOD = WS_WO + (size_t)2 * D * D * 2;
constexpr size_t WS_WTP = WS_MOD + (size_t)2 * NCOND * 3 * D * 4;
constexpr size_t WS_STATS = WS_WTP + (size_t)2 * 4 * 16384 * 4;
constexpr size_t WS_BUF = (WS_STATS + (size_t)M * 16 * 2 * 4 + 4095) & ~(size_t)4095;
constexpr size_t WS_BAR = WS_BUF + 6 * BUF_BYTES;
constexpr size_t WS_END = WS_BAR + 256;
constexpr int LDS_BYTES = 131072 + 4096;

struct Params {
    const float *x_prompt, *x_sample, *state_hgrn, *c_prompt, *c_sample, *w_ada, *b_ada, *norm_g, *w_in, *ln_v_g, *ln_v_b, *w_s, *b_s, *lb_raw, *gnorm_g, *w_pa, *w_pb, *w_o, *final_g;
    float* out; unsigned char* ws;
    int ph_lo, ph_hi;
};

typedef const Params __attribute__((address_space(4))) CParams;
typedef __bf16 bf16x2_t __attribute__((ext_vector_type(2)));
__device__ __forceinline__ unsigned cvt_pk_bf16(float lo, float hi) { const f32x2 v = {lo, hi}; const bf16x2_t h = __builtin_convertvector(v, bf16x2_t); return __builtin_bit_cast(unsigned, h); }
__device__ __forceinline__ float bf_lo(unsigned u) { return __uint_as_float(u << 16); }
__device__ __forceinline__ float bf_hi(unsigned u) { return __uint_as_float(u & 0xffff0000u); }
__device__ __forceinline__ unsigned pk_f16(float a, float b) { f16x2 h; h.x = (_Float16)a; h.y = (_Float16)b; return __builtin_bit_cast(unsigned, h); }
__device__ __forceinline__ float f16_lo(unsigned u) { f16x2 h = __builtin_bit_cast(f16x2, u); return (float)h.x; }
__device__ __forceinline__ float f16_hi(unsigned u) { f16x2 h = __builtin_bit_cast(f16x2, u); return (float)h.y; }
__device__ __forceinline__ float fsigmoid(float x) { return __builtin_amdgcn_rcpf(1.0f + __expf(-x)); }
__device__ __forceinline__ float fsilu(float x) { return x * fsigmoid(x); }
__device__ __forceinline__ float fgelu(float x) { return x * fsigmoid(1.5957691216057308f * (x + 0.044715f * x * x * x)); }
__device__ __forceinline__ float fgelu_silu(float u, float z) {
    const float a = 1.5957691216057308f * (u + 0.044715f * u * u * u);
    return (u * z) * __builtin_amdgcn_rcpf((1.0f + __expf(-a)) * (1.0f + __expf(-z)));
}
__device__ __forceinline__ float wave_sum(float v) {
#pragma unroll
    for (int o = 1; o < 64; o <<= 1) v += __shfl_xor(v, o);
    return v;
}
__device__ __forceinline__ int otid() { int t = threadIdx.x; asm volatile("" : "+v"(t)); return t; }
__device__ __forceinline__ int obid() { int b = blockIdx.x; asm volatile("" : "+s"(b)); return b; }
__device__ __forceinline__ int ogrid() { int g = gridDim.x; asm volatile("" : "+s"(g)); return g; }
__device__ __forceinline__ float xrow16_sum(float x) {
    auto s = __builtin_amdgcn_permlane16_swap(__float_as_uint(x), __float_as_uint(x), false, false);
    x = __uint_as_float(s[0]) + __uint_as_float(s[1]);
    auto t = __builtin_amdgcn_permlane32_swap(__float_as_uint(x), __float_as_uint(x), false, false);
    return __uint_as_float(t[0]) + __uint_as_float(t[1]);
}
template <int CTRL> __device__ __forceinline__ float dpp_mov(float x) { return __builtin_bit_cast(float, __builtin_amdgcn_mov_dpp(__builtin_bit_cast(int, x), CTRL, 0xf, 0xf, true)); }
__device__ __forceinline__ float row16_sum(float x) {
    x += dpp_mov<0xB1>(x); x += dpp_mov<0x4E>(x); x += dpp_mov<0x124>(x); x += dpp_mov<0x128>(x); return x;
}
__device__ __forceinline__ int cond_of_row(int r) { return r < MP ? (r >> 11) : 16 + ((r - MP) >> 6); }

namespace pg8 {
constexpr int BM = 256, BK = 64, HALF = 128, HTB = HALF * BK * 2, STAGE_BYTES = 8 * HTB, NXCD = 8, WGM = 8;
__host__ __device__ __forceinline__ int lds_byte(int r, int c) { const int st = (r >> 4) * 2 + (c >> 5), rr = r & 15, cc = c & 31, ob = rr * 64 + cc * 2; return st * 1024 + (ob ^ (((ob >> 9) & 1) << 5)); }
__host__ __device__ __forceinline__ void stage_rc(int b, int& R, int& C) { const int st = b / 1024, sb = b % 1024, swz = sb ^ (((sb >> 9) & 1) << 5); R = (st >> 1) * 16 + swz / 64; C = (st & 1) * 32 + (swz % 64) / 2; }
__host__ __device__ __forceinline__ int perm32(int rho) { const int n = rho >> 4, i = rho & 15; return 8 * (i >> 2) + 4 * n + (i & 3); }
struct Unit { int pm, pn; };
struct Gemm { const bf16_t* A; const bf16_t* Bt; int M, N, K; };
struct StaticOrder {
    int nM, nN, nwg, G, c;
    __host__ __device__ void init(int M_, int N_, int G_, int c_) { nM = M_ / BM; nN = N_ / BM; nwg = nM * nN; G = G_; c = c_; }
    __host__ __device__ bool next(int i, Unit& u) const {
        const long L = (long)i * G + c; if (L >= nwg) return false;
        int wgid = (int)L; { const int q = nwg / NXCD, r = nwg % NXCD, xcd = wgid % NXCD, off = wgid / NXCD; wgid = (xcd < r ? xcd * (q + 1) : r * (q + 1) + (xcd - r) * q) + off; }
        const int nig = WGM * nN, gid = wgid / nig, fm = gid * WGM, gsz = (nM - fm) < WGM ? (nM - fm) : WGM;
        u.pm = fm + ((wgid % nig) % gsz); u.pn = (wgid % nig) / gsz; return true;
    }
    __device__ __forceinline__ void a_ready(const Unit&) const {}
    __device__ __forceinline__ void done(const Unit&) const {}
};

template <class Epi, class Sched, bool ALIGN_EPI = false, bool SP2 = false>
__device__ __forceinline__ void gemm_phase(LAS unsigned char* lds, const Gemm g, const Sched& S, const Epi& E) {
    const int tid = otid(), wid = __builtin_amdgcn_readfirstlane(tid >> 6), lane = tid & 63, wr = wid >> 2, wc = wid & 3, fr = lane & 15, fq = lane >> 4;
    const int K = g.K, nt = K / BK;
    unsigned voffA[2], voffB[2];
#pragma unroll
    for (int i = 0; i < 2; ++i) { int R, C; stage_rc(tid * 16 + i * 8192, R, C); const int Rb = Epi::PERM ? ((R & ~31) + perm32(R & 31)) : R;
        voffA[i] = (unsigned)(R * K + C) * 2u; voffB[i] = (unsigned)(Rb * K + C) * 2u; }
    const size_t kstep = (size_t)(BK * 2);
    const size_t hstep = (size_t)HALF * K * 2;
    const size_t tstep = 2 * hstep;
    const unsigned ldsw = (unsigned)wid * 1024u;
    const int aoff = lds_byte(wr * 64 + fr, fq * 8), boff = lds_byte(wc * 32 + fr, fq * 8);
#define PG8_SA(b, h) (((b) * 2 + (h)) * HTB)
#define PG8_SB(b, h) ((4 + (b) * 2 + (h)) * HTB)
#define PG8_STAGE(bufoff, gbase, voff) do { _Pragma("unroll") for (int _i = 0; _i < 2; ++_i) \
        __builtin_amdgcn_global_load_lds((const unsigned*)((const char*)(gbase) + (voff)[_i]), (LAS unsigned*)(lds + (bufoff) + ldsw + _i * 8192), 16, 0, 0); } while (0)
#define PG8_LDA(dst, b, h) do { _Pragma("unroll") for (int m = 0; m < 4; ++m) _Pragma("unroll") for (int k = 0; k < 2; ++k) dst[m][k] = *(const LAS bf16x8*)(lds + PG8_SA(b, h) + aoff + m * 2048 + k * 1024); } while (0)
#define PG8_LDB(dst, b, h) do { _Pragma("unroll") for (int n = 0; n < 2; ++n) _Pragma("unroll") for (int k = 0; k < 2; ++k) dst[n][k] = *(const LAS bf16x8*)(lds + PG8_SB(b, h) + boff + n * 2048 + k * 1024); } while (0)
#define PG8_MMA(ai, bj, At, Bt) do { __builtin_amdgcn_s_setprio(1); _Pragma("unroll") for (int m = 0; m < 4; ++m) _Pragma("unroll") for (int n = 0; n < 2; ++n) _Pragma("unroll") for (int k = 0; k < 2; ++k) \
        acc[ai][bj][m][n] = __builtin_amdgcn_mfma_f32_16x16x32_bf16(Bt[n][k], At[m][k], acc[ai][bj][m][n], 0, 0, 0); __builtin_amdgcn_s_setprio(0); } while (0)
#define PG8_WAIT_V(n) asm volatile("s_waitcnt vmcnt(" #n ")" ::: "memory")
#define PG8_WAIT_L(n) asm volatile("s_waitcnt lgkmcnt(" #n ")" ::: "memory")
#define PG8_BAR __builtin_amdgcn_s_barrier()
#define PG8_SCHED __builtin_amdgcn_sched_barrier(0)
    Unit cur, nxt; int ui = 0;
    if (!S.next(0, cur)) return;
    f32x4 acc[2][2][4][2];
#pragma unroll
    for (int a = 0; a < 2; ++a)
#pragma unroll
        for (int b = 0; b < 2; ++b)
#pragma unroll
            for (int m = 0; m < 4; ++m)
#pragma unroll
                for (int n = 0; n < 2; ++n) acc[a][b][m][n] = (f32x4){0.f, 0.f, 0.f, 0.f};
    bf16x8 At[4][2], B0[2][2], B1[2][2];
    const char* cA = (const char*)g.A + (size_t)cur.pm * tstep; const char* cB = (const char*)g.Bt + (size_t)cur.pn * tstep;
    S.a_ready(cur);
    if constexpr (SP2) {
        PG8_STAGE(PG8_SB(0, 0), cB, voffB); PG8_STAGE(PG8_SB(0, 1), cB + hstep, voffB); PG8_STAGE(PG8_SA(0, 0), cA, voffA); PG8_STAGE(PG8_SA(0, 1), cA + hstep, voffA);
        if (wr == 1) PG8_BAR;
        PG8_WAIT_V(2); PG8_BAR;
        PG8_STAGE(PG8_SB(1, 0), cB + kstep, voffB); PG8_STAGE(PG8_SA(1, 0), cA + kstep, voffA); PG8_STAGE(PG8_SB(1, 1), cB + hstep + kstep, voffB);
        PG8_WAIT_V(6); PG8_BAR;
    } else {
        PG8_STAGE(PG8_SB(0, 0), cB, voffB); PG8_STAGE(PG8_SA(0, 0), cA, voffA); PG8_STAGE(PG8_SB(0, 1), cB + hstep, voffB); PG8_STAGE(PG8_SA(0, 1), cA + hstep, voffA);
        if (wr == 1) PG8_BAR;
        PG8_WAIT_V(4); PG8_BAR;
        PG8_STAGE(PG8_SB(1, 0), cB + kstep, voffB); PG8_STAGE(PG8_SA(1, 0), cA + kstep, voffA); PG8_STAGE(PG8_SB(1, 1), cB + hstep + kstep, voffB);
        PG8_WAIT_V(6); PG8_BAR;
    }
    for (;;) {
        const bool has_next = S.next(ui + 1, nxt);
        const char* nA = has_next ? (const char*)g.A + (size_t)nxt.pm * tstep : cA; const char* nB = has_next ? (const char*)g.Bt + (size_t)nxt.pn * tstep : cB;
        for (int t = 0; t < nt; t += 2) {
            const bool last = (t == nt - 2);
            const char* a1 = cA + (size_t)(t + 1) * kstep;
            const char* a2 = last ? nA : cA + (size_t)(t + 2) * kstep; const char* b2 = last ? nB : cB + (size_t)(t + 2) * kstep;
            const char* a3 = a2 + kstep; const char* b3 = b2 + kstep;
            if (last && has_next) S.a_ready(nxt);
            if constexpr (SP2) {
            PG8_LDB(B0, 0, 0); PG8_LDB(B1, 0, 1); PG8_SCHED; PG8_LDA(At, 0, 0); PG8_STAGE(PG8_SA(1, 1), a1 + hstep, voffA);
            PG8_WAIT_V(8); PG8_WAIT_L(0); PG8_BAR; PG8_MMA(0, 0, At, B0); PG8_MMA(0, 1, At, B1); PG8_BAR; PG8_SCHED;
            PG8_LDA(At, 0, 1); PG8_STAGE(PG8_SB(0, 0), b2, voffB); PG8_STAGE(PG8_SB(0, 1), b2 + hstep, voffB); PG8_STAGE(PG8_SA(0, 0), a2, voffA);
            PG8_WAIT_V(8); PG8_WAIT_L(0); PG8_BAR; PG8_MMA(1, 0, At, B0); PG8_MMA(1, 1, At, B1); PG8_BAR; PG8_SCHED;
            PG8_LDB(B0, 1, 0); PG8_LDB(B1, 1, 1); PG8_SCHED; PG8_LDA(At, 1, 0); PG8_STAGE(PG8_SA(0, 1), a2 + hstep, voffA);
            PG8_WAIT_V(8); PG8_WAIT_L(0); PG8_BAR; PG8_MMA(0, 0, At, B0); PG8_MMA(0, 1, At, B1); PG8_BAR; PG8_SCHED;
            PG8_LDA(At, 1, 1); PG8_STAGE(PG8_SB(1, 0), b3, voffB); PG8_STAGE(PG8_SB(1, 1), b3 + hstep, voffB); PG8_STAGE(PG8_SA(1, 0), a3, voffA);
            PG8_WAIT_V(8); PG8_WAIT_L(0); PG8_BAR; PG8_MMA(1, 0, At, B0); PG8_MMA(1, 1, At, B1); PG8_BAR; PG8_SCHED;
            } else {
            PG8_LDB(B0, 0, 0); PG8_SCHED; PG8_LDA(At, 0, 0); PG8_STAGE(PG8_SA(1, 1), a1 + hstep, voffA);
            PG8_WAIT_L(8); PG8_BAR; PG8_WAIT_L(0); PG8_MMA(0, 0, At, B0); PG8_BAR; PG8_SCHED;
            PG8_LDB(B1, 0, 1); PG8_STAGE(PG8_SB(0, 0), b2, voffB);
            PG8_BAR; PG8_WAIT_L(0); PG8_MMA(0, 1, At, B1); PG8_BAR;
            PG8_LDA(At, 0, 1); PG8_STAGE(PG8_SA(0, 0), a2, voffA);
            PG8_BAR; PG8_WAIT_L(0); PG8_MMA(1, 0, At, B0); PG8_BAR; PG8_SCHED;
            PG8_STAGE(PG8_SB(0, 1), b2 + hstep, voffB);
            PG8_WAIT_V(6); PG8_BAR; PG8_MMA(1, 1, At, B1); PG8_BAR;
            PG8_LDB(B0, 1, 0); PG8_SCHED; PG8_LDA(At, 1, 0); PG8_STAGE(PG8_SA(0, 1), a2 + hstep, voffA);
            PG8_WAIT_L(8); PG8_BAR; PG8_WAIT_L(0); PG8_MMA(0, 0, At, B0); PG8_BAR; PG8_SCHED;
            PG8_LDB(B1, 1, 1); PG8_STAGE(PG8_SB(1, 0), b3, voffB);
            PG8_BAR; PG8_WAIT_L(0); PG8_MMA(0, 1, At, B1); PG8_BAR;
            PG8_LDA(At, 1, 1); PG8_STAGE(PG8_SA(1, 0), a3, voffA);
            PG8_BAR; PG8_WAIT_L(0); PG8_MMA(1, 0, At, B0); PG8_BAR; PG8_SCHED;
            PG8_STAGE(PG8_SB(1, 1), b3 + hstep, voffB);
            PG8_WAIT_V(6); PG8_BAR; PG8_MMA(1, 1, At, B1); PG8_BAR;
            }
        }
        if constexpr (ALIGN_EPI) { if (wr == 0) PG8_BAR; }
        E(acc, cur, wr, wc, fr, fq); S.done(cur);
        if (!has_next) break;
#pragma unroll
        for (int a = 0; a < 2; ++a)
#pragma unroll
            for (int b = 0; b < 2; ++b)
#pragma unroll
                for (int m = 0; m < 4; ++m)
#pragma unroll
                    for (int n = 0; n < 2; ++n) acc[a][b][m][n] = (f32x4){0.f, 0.f, 0.f, 0.f};
        cur = nxt; cA = nA; cB = nB; ++ui;
        if constexpr (ALIGN_EPI) { if (wr == 1) PG8_BAR; }
    }
    PG8_WAIT_V(0);
    if constexpr (!ALIGN_EPI) { if (wr == 0) PG8_BAR; }
    PG8_BAR;
#undef PG8_SA
#undef PG8_SB
#undef PG8_STAGE
#undef PG8_LDA
#undef PG8_LDB
#undef PG8_MMA
#undef PG8_WAIT_V
#undef PG8_WAIT_L
#undef PG8_BAR
#undef PG8_SCHED
}
}
using pg8::Unit;

struct EpiB {
    static constexpr bool PERM = true;
    bf16_t *Q, *F, *I, *ZB, *GB;
    __device__ __forceinline__ void operator()(const f32x4 (&acc)[2][2][4][2], const Unit& u, int wr, int wc, int fr, int fq) const {
        const int seg = u.pn >> 2;
        bf16_t* base = seg == 0 ? Q : seg == 1 ? F : seg == 2 ? I : seg == 3 ? ZB : GB;
        const int col0 = (u.pn & 3) * 256 + wc * 32 + 8 * fq, row0 = u.pm * 256 + wr * 64 + fr;
#pragma unroll
        for (int ai = 0; ai < 2; ++ai)
#pragma unroll
            for (int m = 0; m < 4; ++m) { bf16_t* rowp = base + (size_t)(row0 + ai * 128 + m * 16) * D + col0;
#pragma unroll
                for (int bj = 0; bj < 2; ++bj) { float v[8];
#pragma unroll
                    for (int j = 0; j < 4; ++j) { v[j] = acc[ai][bj][m][0][j]; v[4 + j] = acc[ai][bj][m][1][j]; }
                    u32x4 w;
                    if (seg == 1) { w.x = pk_f16(v[0], v[1]); w.y = pk_f16(v[2], v[3]); w.z = pk_f16(v[4], v[5]); w.w = pk_f16(v[6], v[7]); }
                    else {
                        if (seg == 0 || seg == 4) {
#pragma unroll
                            for (int j = 0; j < 8; ++j) { const float s = fsigmoid(v[j]); v[j] = (seg == 4) ? s : v[j] * s; } }
                        w.x = cvt_pk_bf16(v[0], v[1]); w.y = cvt_pk_bf16(v[2], v[3]); w.z = cvt_pk_bf16(v[4], v[5]); w.w = cvt_pk_bf16(v[6], v[7]); }
                    *(u32x4*)(rowp + bj * 128) = w; } }
    }
};
struct EpiA {
    static constexpr bool PERM = true;
    bf16_t *UZ, *V, *GA; float* stats;
    __device__ __forceinline__ void operator()(const f32x4 (&acc)[2][2][4][2], const Unit& u, int wr, int wc, int fr, int fq) const {
        const int row0 = u.pm * 256 + wr * 64 + fr;
        if (u.pn < 8) {
            const int col0 = u.pn * 128 + wc * 32 + 8 * fq;
#pragma unroll
            for (int ai = 0; ai < 2; ++ai)
#pragma unroll
                for (int m = 0; m < 4; ++m) { float v[8];
#pragma unroll
                    for (int j = 0; j < 4; ++j) { v[j] = fgelu_silu(acc[ai][0][m][0][j], acc[ai][1][m][0][j]); v[4 + j] = fgelu_silu(acc[ai][0][m][1][j], acc[ai][1][m][1][j]); }
                    u32x4 w; w.x = cvt_pk_bf16(v[0], v[1]); w.y = cvt_pk_bf16(v[2], v[3]); w.z = cvt_pk_bf16(v[4], v[5]); w.w = cvt_pk_bf16(v[6], v[7]);
                    *(u32x4*)(UZ + (size_t)(row0 + ai * 128 + m * 16) * D + col0) = w; }
        } else if (u.pn < 12) {
            const int pnl = u.pn - 8, col0 = pnl * 256 + wc * 32 + 8 * fq;
#pragma unroll
            for (int ai = 0; ai < 2; ++ai)
#pragma unroll
                for (int m = 0; m < 4; ++m) { const int row = row0 + ai * 128 + m * 16; float s = 0.f, ss = 0.f;
#pragma unroll
                    for (int bj = 0; bj < 2; ++bj) { float v[8];
#pragma unroll
                        for (int j = 0; j < 4; ++j) { v[j] = fgelu(acc[ai][bj][m][0][j]); v[4 + j] = fgelu(acc[ai][bj][m][1][j]); }
#pragma unroll
                        for (int j = 0; j < 8; ++j) { s += v[j]; ss += v[j] * v[j]; }
                        u32x4 w; w.x = cvt_pk_bf16(v[0], v[1]); w.y = cvt_pk_bf16(v[2], v[3]); w.z = cvt_pk_bf16(v[4], v[5]); w.w = cvt_pk_bf16(v[6], v[7]);
                        *(u32x4*)(V + (size_t)row * D + col0 + bj * 128) = w; }
                    s = xrow16_sum(s); ss = xrow16_sum(ss);
                    *(f32x2*)(stats + ((size_t)row * 16 + pnl * 4 + wc) * 2) = (f32x2){s, ss}; }
        } else {
            const int col0 = (u.pn - 12) * 256 + wc * 32 + 8 * fq;
#pragma unroll
            for (int ai = 0; ai < 2; ++ai)
#pragma unroll
                for (int m = 0; m < 4; ++m)
#pragma unroll
                    for (int bj = 0; bj < 2; ++bj) { float v[8];
#pragma unroll
                        for (int j = 0; j < 4; ++j) { v[j] = fsigmoid(acc[ai][bj][m][0][j]); v[4 + j] = fsigmoid(acc[ai][bj][m][1][j]); }
                        u32x4 w; w.x = cvt_pk_bf16(v[0], v[1]); w.y = cvt_pk_bf16(v[2], v[3]); w.z = cvt_pk_bf16(v[4], v[5]); w.w = cvt_pk_bf16(v[6], v[7]);
                        *(u32x4*)(GA + (size_t)(row0 + ai * 128 + m * 16) * D + col0 + bj * 128) = w; }
        }
    }
};
template <bool ADD> struct EpiGate {
    static constexpr bool PERM = true;
    const bf16_t* G; const bf16_t* T; bf16_t* O;
    __device__ __forceinline__ void operator()(const f32x4 (&acc)[2][2][4][2], const Unit& u, int wr, int wc, int fr, int fq) const {
        const int col0 = u.pn * 256 + wc * 32 + 8 * fq, row0 = u.pm * 256 + wr * 64 + fr;
#pragma unroll
        for (int ai = 0; ai < 2; ++ai)
#pragma unroll
            for (int m = 0; m < 4; ++m) { const size_t off = (size_t)(row0 + ai * 128 + m * 16) * D + col0;
#pragma unroll
                for (int bj = 0; bj < 2; ++bj) { const u32x4 gq = *(const u32x4*)(G + off + bj * 128);
                    const unsigned gw[4] = {gq.x, gq.y, gq.z, gq.w}; float v[8];
#pragma unroll
                    for (int j = 0; j < 2; ++j) { v[2 * j] = bf_lo(gw[j]) * acc[ai][bj][m][0][2 * j]; v[2 * j + 1] = bf_hi(gw[j]) * acc[ai][bj][m][0][2 * j + 1];
                        v[4 + 2 * j] = bf_lo(gw[2 + j]) * acc[ai][bj][m][1][2 * j]; v[5 + 2 * j] = bf_hi(gw[2 + j]) * acc[ai][bj][m][1][2 * j + 1]; }
                    if (ADD) { const u32x4 tq = *(const u32x4*)(T + off + bj * 128); const unsigned tw[4] = {tq.x, tq.y, tq.z, tq.w};
#pragma unroll
                        for (int j = 0; j < 4; ++j) { v[2 * j] += bf_lo(tw[j]); v[2 * j + 1] += bf_hi(tw[j]); } }
                    u32x4 w; w.x = cvt_pk_bf16(v[0], v[1]); w.y = cvt_pk_bf16(v[2], v[3]); w.z = cvt_pk_bf16(v[4], v[5]); w.w = cvt_pk_bf16(v[6], v[7]);
                    *(u32x4*)(O + off + bj * 128) = w; } }
    }
};
struct EpiO {
    static constexpr bool PERM = false;
    const float *xp, *xs; float* xo; const float* mod;
    __device__ __forceinline__ void operator()(const f32x4 (&acc)[2][2][4][2], const Unit& u, int wr, int wc, int fr, int fq) const {
        const unsigned col0 = (unsigned)(u.pn * 256 + wc * 32 + 4 * fq);
        const float* xt = ((u.pm < MP / 256) ? xp : xs - (size_t)MP * D) + (size_t)u.pm * 256 * D;
        float* ot = xo + (size_t)u.pm * 256 * D;
#pragma unroll
        for (int ai = 0; ai < 2; ++ai) {
            const int ci = cond_of_row(u.pm * 256 + ai * 128 + wr * 64);
            const float* gate = mod + (size_t)ci * 3 * D + 2 * D;
            f32x4 gv[2][2];
#pragma unroll
            for (int bj = 0; bj < 2; ++bj)
#pragma unroll
                for (int n = 0; n < 2; ++n) gv[bj][n] = *(const f32x4*)(gate + (col0 + bj * 128 + n * 16));
#pragma unroll
            for (int m = 0; m < 4; ++m) { const unsigned off = (unsigned)(ai * 128 + wr * 64 + m * 16 + fr) * D + col0;
#pragma unroll
                for (int bj = 0; bj < 2; ++bj)
#pragma unroll
                    for (int n = 0; n < 2; ++n) { const f32x4 xv = *(const f32x4*)(xt + (off + bj * 128 + n * 16));
                        *(f32x4*)(ot + (off + bj * 128 + n * 16)) = xv + gv[bj][n] * acc[ai][bj][m][n]; }
                asm volatile("" ::: "memory"); } }
    }
};


__device__ __forceinline__ int win_src_col(int n) {
    if (n < 4096) return 3072 + n;
    if (n < 5120) return 8192 + (n - 4096);
    n -= 5120;
    if (n < 2048) { const int t = n >> 8, r = n & 255; return r < 128 ? 128 * t + r : 2048 + 128 * t + (r - 128); }
    if (n < 3072) return 1024 + (n - 2048);
    return 7168 + (n - 3072);
}
__device__ __forceinline__ void transpose_item(const float* W, int ldn, int n0s, int k0, bf16_t* WT, int n0d, LAS float* scr, int lane) {
#pragma unroll 8
    for (int i = 0; i < 32; ++i) { const int kk = 2 * i + (lane >> 5); scr[kk * 33 + (lane & 31)] = W[(size_t)(k0 + kk) * ldn + n0s + (lane & 31)]; }
    __builtin_amdgcn_s_waitcnt(0xc07f); asm volatile("" ::: "memory");
    const int c = lane & 7;
#pragma unroll
    for (int j = 0; j < 4; ++j) { const int n = (lane >> 3) + 8 * j; const LAS float* s = scr + (8 * c) * 33 + n;
        u32x4 o; o.x = cvt_pk_bf16(s[0 * 33], s[1 * 33]); o.y = cvt_pk_bf16(s[2 * 33], s[3 * 33]); o.z = cvt_pk_bf16(s[4 * 33], s[5 * 33]); o.w = cvt_pk_bf16(s[6 * 33], s[7 * 33]);
        *(u32x4*)(WT + (size_t)(n0d + n) * D + k0 + 8 * c) = o; }
    __builtin_amdgcn_s_waitcnt(0xc07f); asm volatile("" ::: "memory");
}
__device__ __forceinline__ void phase_prep(CParams* p, LAS unsigned char* lds) {
    const int tid = otid(), lane = tid & 63, wave = tid >> 6, G = ogrid(), bid = obid();
    {
        LAS float* sc = (LAS float*)lds;
        LAS float* part = sc + 8192;
        for (int it = bid; it < 576; it += G) {
            const int l = it / 288, rg = (it % 288) / 48, cb = it % 48;
            __syncthreads();
            for (int e = tid; e < 8 * 1024; e += 512) { const int r = e >> 10, k = e & 1023, ci = rg * 8 + r;
                const float cv = ci < 16 ? p->c_prompt[(size_t)ci * D + k] : p->c_sample[(size_t)(ci - 16) * D + k]; sc[k * 8 + r] = fsilu(cv); }
            __syncthreads();
            const int col = cb * 64 + lane; const float* w = p->w_ada + (size_t)l * D * 3 * D + (size_t)(wave * 128) * 3 * D + col;
            float a[8] = {0.f, 0.f, 0.f, 0.f, 0.f, 0.f, 0.f, 0.f};
            for (int k8 = 0; k8 < 128; k8 += 8) { float wv[8];
#pragma unroll
                for (int u = 0; u < 8; ++u) wv[u] = w[(size_t)(k8 + u) * 3 * D];
#pragma unroll
                for (int u = 0; u < 8; ++u) { const LAS float* s = sc + (wave * 128 + k8 + u) * 8; const f32x4 s0 = *(const LAS f32x4*)s, s1 = *(const LAS f32x4*)(s + 4);
                    a[0] += s0.x * wv[u]; a[1] += s0.y * wv[u]; a[2] += s0.z * wv[u]; a[3] += s0.w * wv[u]; a[4] += s1.x * wv[u]; a[5] += s1.y * wv[u]; a[6] += s1.z * wv[u]; a[7] += s1.w * wv[u]; } }
#pragma unroll
            for (int r = 0; r < 8; ++r) part[(wave * 8 + r) * 64 + lane] = a[r];
            __syncthreads();
            { float s = 0.f;
#pragma unroll
              for (int w2 = 0; w2 < 8; ++w2) s += part[(w2 * 8 + wave) * 64 + lane];
              ((float*)(p->ws + WS_MOD))[((size_t)l * NCOND + rg * 8 + wave) * 3 * D + col] = s + p->b_ada[(size_t)l * 3 * D + col]; }
        }
        __syncthreads();
    }
    {
        LAS float* scr = (LAS float*)(lds + wave * 8704);
        const int gw = bid * 8 + wave, NGW = G * 8;
        constexpr int I_IN = 16 * (NIN / 32), I_SQ = 16 * (D / 32), PER_L = I_IN + 3 * I_SQ;
        for (int it = gw; it < 2 * PER_L; it += NGW) { const int l = it / PER_L; int r = it % PER_L;
            if (r < I_IN) { const int kb = r / (NIN / 32), nb = r % (NIN / 32);
                transpose_item(p->w_in + (size_t)l * D * NIN, NIN, win_src_col(nb * 32), kb * 64, (bf16_t*)(p->ws + WS_WIN) + (size_t)l * NIN * D, nb * 32, scr, lane); continue; }
            r -= I_IN; const int which = r / I_SQ; r %= I_SQ; const int kb = r / (D / 32), nb = r % (D / 32);
            const float* src = (which == 0 ? p->w_pa : which == 1 ? p->w_pb : p->w_o) + (size_t)l * D * D;
            bf16_t* dst = (bf16_t*)(p->ws + (which == 0 ? WS_WPA : which == 1 ? WS_WPB : WS_WO)) + (size_t)l * D * D;
            transpose_item(src, D, nb * 32, kb * 64, dst, nb * 32, scr, lane); }
    }
}

__device__ __forceinline__ void phase_norm(CParams* p, int l, const float* xp, const float* xs, bf16_t* H) {
    const int tid = otid(), lane = tid & 63, gw = obid() * 8 + (tid >> 6), NGW = ogrid() * 8;
    const float* g = p->norm_g + (size_t)l * D; const float* mod = (const float*)(p->ws + WS_MOD) + (size_t)l * NCOND * 3 * D;
    for (int row = gw; row < M; row += NGW) {
        const float* xr = row < MP ? xp + (size_t)row * D : xs + (size_t)(row - MP) * D;
        const float* mrow = mod + (size_t)cond_of_row(row) * 3 * D;
        f32x4 v[4]; float s = 0.f;
#pragma unroll
        for (int j = 0; j < 4; ++j) { v[j] = *(const f32x4*)(xr + 4 * lane + 256 * j); s += (v[j].x * v[j].x + v[j].y * v[j].y) + (v[j].z * v[j].z + v[j].w * v[j].w); }
        const float r = rsqrtf(wave_sum(s) * (1.f / D) + EPS);
#pragma unroll
        for (int j = 0; j < 4; ++j) { const int c = 4 * lane + 256 * j; const f32x4 gv = *(const f32x4*)(g + c), sh = *(const f32x4*)(mrow + c), sc = *(const f32x4*)(mrow + D + c);
            const f32x4 h = (v[j] * r) * gv * (sc + 1.0f) + sh;
            u32x2 w; w.x = cvt_pk_bf16(h.x, h.y); w.y = cvt_pk_bf16(h.z, h.w); *(u32x2*)(H + (size_t)row * D + c) = w; }
    }
}
__device__ __forceinline__ void phase_final(CParams* p) {
    const int tid = otid(), lane = tid & 63, gw = obid() * 8 + (tid >> 6), NGW = ogrid() * 8;
    for (int row = gw; row < M; row += NGW) {
        float* xr = p->out + OUT_Y + (size_t)row * D;
        f32x4 v[4]; float s = 0.f;
#pragma unroll
        for (int j = 0; j < 4; ++j) { v[j] = *(const f32x4*)(xr + 4 * lane + 256 * j); s += (v[j].x * v[j].x + v[j].y * v[j].y) + (v[j].z * v[j].z + v[j].w * v[j].w); }
        const float r = rsqrtf(wave_sum(s) * (1.f / D) + EPS);
#pragma unroll
        for (int j = 0; j < 4; ++j) { const int c = 4 * lane + 256 * j; const f32x4 gv = *(const f32x4*)(p->final_g + c); *(f32x4*)(xr + c) = (v[j] * r) * gv; }
    }
}

__device__ __forceinline__ void phase_scan(CParams* p, int l, const bf16_t* Q, const bf16_t* F, bf16_t* I, float* SQ, LAS unsigned char* lds) {
    const int tid = otid(), G = ogrid(), bid = obid();
    LAS float* fS = (LAS float*)lds; LAS float* kS = fS + 2048; LAS float* qS = kS + 2048; LAS float* iS = qS + 2048; LAS float* op = iS + 2048;
    const int lane = tid & 63, kg = lane & 15, vg = (tid >> 6) * 4 + (lane >> 4), k0 = kg * 8;
    const int st = tid >> 5, sc4 = (tid & 31) * 4, vl2 = (tid & 31) * 2;
    for (int it = bid; it < 768; it += G) {
        const bool prompt = it < 256; const int id = prompt ? it : it - 256, b = id >> 4, h = (id >> 1) & 7, vh = id & 1;
        const int T = prompt ? 2048 : 64, row0 = prompt ? b * 2048 : MP + b * 64, v0 = vh * 64 + vg * 2;
        float* sout = p->out + (prompt ? OUT_SP + ((size_t)(l * 16 + b) * 8 + h) * 16384 : OUT_SS + ((size_t)(l * 32 + b) * 8 + h) * 16384);
        f32x2 S[8];
        if (prompt) {
#pragma unroll
            for (int j = 0; j < 8; ++j) S[j] = (f32x2){0.f, 0.f};
        } else { const float* sin = p->state_hgrn + ((size_t)(l * 32 + b) * 8 + h) * 16384;
#pragma unroll
            for (int j = 0; j < 8; ++j) S[j] = *(const f32x2*)(sin + (k0 + j) * 128 + v0); }
        float lb[4];
#pragma unroll
        for (int j = 0; j < 4; ++j) { const int hk = h * 128 + sc4 + j; lb[j] = l == 0 ? 0.f : fsigmoid(p->lb_raw[D + hk] - p->lb_raw[hk]); }
        const size_t off0 = (size_t)(row0 + st) * D + h * 128 + sc4;
        u32x2 qw = *(const u32x2*)(Q + off0), fw = *(const u32x2*)(F + off0), iw = *(const u32x2*)(I + off0);
        auto stage = [&](int tnext) {
            *(LAS f32x4*)(qS + st * 128 + sc4) = (f32x4){bf_lo(qw.x), bf_hi(qw.x), bf_lo(qw.y), bf_hi(qw.y)};
            *(LAS f32x4*)(iS + st * 128 + sc4) = (f32x4){bf_lo(iw.x), bf_hi(iw.x), bf_lo(iw.y), bf_hi(iw.y)};
            const float z[4] = {f16_lo(fw.x), f16_hi(fw.x), f16_lo(fw.y), f16_hi(fw.y)}; f32x4 fv;
#pragma unroll
            for (int j = 0; j < 4; ++j) { const float sg = fsigmoid(z[j]); fv[j] = lb[j] + (1.f - lb[j]) * sg; }
            *(LAS f32x4*)(fS + st * 128 + sc4) = fv;
            if (tnext < T) { const size_t off = off0 + (size_t)tnext * D; qw = *(const u32x2*)(Q + off); fw = *(const u32x2*)(F + off); iw = *(const u32x2*)(I + off); }
        };
        __syncthreads();
        stage(16);
        for (int t0 = 0; t0 < T; t0 += 16) {
            __syncthreads();
            {
                f32x2 iv = *(const LAS f32x2*)(iS + v0);
                f32x4 fa = *(const LAS f32x4*)(fS + k0), fb = *(const LAS f32x4*)(fS + k0 + 4);
                f32x4 qa = *(const LAS f32x4*)(qS + k0), qb = *(const LAS f32x4*)(qS + k0 + 4);
                f32x2 oacc[16];
#pragma unroll
                for (int t = 0; t < 16; ++t) {
                    const int tn = (t + 1 < 16) ? t + 1 : t;
                    const f32x2 ivn = *(const LAS f32x2*)(iS + tn * 128 + v0);
                    const f32x4 fan = *(const LAS f32x4*)(fS + tn * 128 + k0), fbn = *(const LAS f32x4*)(fS + tn * 128 + k0 + 4);
                    const f32x4 qan = *(const LAS f32x4*)(qS + tn * 128 + k0), qbn = *(const LAS f32x4*)(qS + tn * 128 + k0 + 4);
                    f32x2 o = (f32x2){0.f, 0.f};
#pragma unroll
                    for (int j = 0; j < 4; ++j) { S[j] = (S[j] - iv) * fa[j] + iv; o += S[j] * qa[j]; S[4 + j] = (S[4 + j] - iv) * fb[j] + iv; o += S[4 + j] * qb[j]; }
                    oacc[t] = o;
                    iv = ivn; fa = fan; fb = fbn; qa = qan; qb = qbn;
                }
                const bool b0 = (kg & 1) != 0, b1 = (kg & 2) != 0, b2 = (kg & 4) != 0, b3 = (kg & 8) != 0;
                f32x2 a8[8], a4[4], a2[2];
#pragma unroll
                for (int j = 0; j < 8; ++j) { const f32x2 keep = b0 ? oacc[8 + j] : oacc[j], send = b0 ? oacc[j] : oacc[8 + j];
                    a8[j].x = keep.x + dpp_mov<0xB1>(send.x); a8[j].y = keep.y + dpp_mov<0xB1>(send.y); }
#pragma unroll
                for (int j = 0; j < 4; ++j) { const f32x2 keep = b1 ? a8[4 + j] : a8[j], send = b1 ? a8[j] : a8[4 + j];
                    a4[j].x = keep.x + dpp_mov<0x4E>(send.x); a4[j].y = keep.y + dpp_mov<0x4E>(send.y); }
#pragma unroll
                for (int j = 0; j < 2; ++j) { const f32x2 keep = b3 ? a4[2 + j] : a4[j], send = b3 ? a4[j] : a4[2 + j];
                    a2[j].x = keep.x + dpp_mov<0x128>(send.x); a2[j].y = keep.y + dpp_mov<0x128>(send.y); }
                { const f32x2 keep = b2 ? a2[1] : a2[0], send = b2 ? a2[0] : a2[1]; f32x2 r;
                  r.x = keep.x + dpp_mov<0x1B>(dpp_mov<0x141>(send.x)); r.y = keep.y + dpp_mov<0x1B>(dpp_mov<0x141>(send.y));
                  const int tok = (b0 ? 8 : 0) + (b1 ? 4 : 0) + (b3 ? 2 : 0) + (b2 ? 1 : 0);
                  *(LAS f32x2*)(op + tok * 64 + vg * 2) = r; }
            }
            __syncthreads();
            { const f32x2 o = *(const LAS f32x2*)(op + st * 64 + vl2); float ss = o.x * o.x + o.y * o.y;
#pragma unroll
              for (int w = 1; w < 32; w <<= 1) ss += __shfl_xor(ss, w);
              const int row = row0 + t0 + st;
              if ((tid & 31) == 0) SQ[((size_t)row * 8 + h) * 2 + vh] = ss;
              *(unsigned*)(I + (size_t)row * D + h * 128 + vh * 64 + vl2) = cvt_pk_bf16(o.x, o.y); }
            if (t0 + 16 < T) stage(t0 + 32);
        }
#pragma unroll
        for (int j = 0; j < 8; ++j) *(f32x2*)(sout + (k0 + j) * 128 + v0) = S[j];
    }
}
__device__ __forceinline__ void phase_hnorm(CParams* p, int l, const bf16_t* O, bf16_t* Q, const bf16_t* ZB, const float* SQ) {
    const int tid = otid(), G = ogrid(), bid = obid();
    const float* gnp = p->gnorm_g + (size_t)l * D;
    for (int idx = bid * 512 + tid; idx < M * 128; idx += G * 512) {
        const int row = idx >> 7, c8 = (idx & 127) * 8, h = c8 >> 7;
        const f32x2 sq = *(const f32x2*)(SQ + ((size_t)row * 8 + h) * 2);
        const float r = rsqrtf((sq.x + sq.y) * (1.f / 128.f) + EPS);
        const u32x4 ow = *(const u32x4*)(O + (size_t)row * D + c8), zw = *(const u32x4*)(ZB + (size_t)row * D + c8);
        const f32x4 g0 = *(const f32x4*)(gnp + c8), g1 = *(const f32x4*)(gnp + c8 + 4);
        const unsigned oa[4] = {ow.x, ow.y, ow.z, ow.w}, za[4] = {zw.x, zw.y, zw.z, zw.w}; const float ga[8] = {g0.x, g0.y, g0.z, g0.w, g1.x, g1.y, g1.z, g1.w};
        u32x4 w; unsigned wa[4];
#pragma unroll
        for (int j = 0; j < 4; ++j) wa[j] = cvt_pk_bf16((bf_lo(oa[j]) * r) * ga[2 * j] * fsilu(bf_lo(za[j])), (bf_hi(oa[j]) * r) * ga[2 * j + 1] * fsilu(bf_hi(za[j])));
        w.x = wa[0]; w.y = wa[1]; w.z = wa[2]; w.w = wa[3];
        *(u32x4*)(Q + (size_t)row * D + c8) = w;
    }
}

__device__ __forceinline__ void phase_gmlp(CParams* p, int l, bf16_t* UZ, const bf16_t* V, LAS unsigned char* lds) {
    const int tid = otid(), G = ogrid(), bid = obid();
    constexpr int STR = 272;
    LAS unsigned char* vnT = lds;
    LAS unsigned char* Wb = lds + 256 * STR;
    LAS float* rs = (LAS float*)(lds + 384 * STR);
    const float* stats = (const float*)(p->ws + WS_STATS);
    const int lane = tid & 63, wave = tid >> 6, fr = lane & 15, fq = lane >> 4;
    int g_staged = -1;
    for (int it = bid; it < 288 * 4; it += G) {
        const int cix = it >> 2, g = it & 3, cb = g * 256;
        const bool prompt = cix < 256; const int R = prompt ? 128 : 64, row0 = prompt ? cix * 128 : MP + (cix - 256) * 64;
        __syncthreads();
        u32x4 vq[8];
#pragma unroll
        for (int i = 0; i < 8; ++i) { const int u = tid + 512 * i;
            if (u < R * 32) { const int s = prompt ? (u & 127) : (u & 63), c8 = (prompt ? (u >> 7) : (u >> 6)) * 8; vq[i] = *(const u32x4*)(V + (size_t)(row0 + s) * D + cb + c8); } }
        if (tid < R) { const float* sp = stats + (size_t)(row0 + tid) * 32; float s = 0.f, ss = 0.f;
#pragma unroll
            for (int j = 0; j < 16; ++j) { const f32x2 a2 = *(const f32x2*)(sp + 2 * j); s += a2.x; ss += a2.y; }
            const float mu = s * (1.f / D), var = fmaxf(ss * (1.f / D) - mu * mu, 0.f); rs[2 * tid] = mu; rs[2 * tid + 1] = rsqrtf(var + EPS); }
        if (g != g_staged) { g_staged = g; const float* wsrc = p->w_s + (size_t)(l * 4 + g) * 16384;
#pragma unroll
          for (int i = 0; i < 8; ++i) { const int u = tid + 512 * i, t = u >> 5, s4 = (u & 31) * 4; f32x4 w4 = *(const f32x4*)(wsrc + t * 128 + s4);
              w4.x = (s4 + 0 <= t) ? w4.x : 0.f; w4.y = (s4 + 1 <= t) ? w4.y : 0.f; w4.z = (s4 + 2 <= t) ? w4.z : 0.f; w4.w = (s4 + 3 <= t) ? w4.w : 0.f;
              u32x2 q; q.x = cvt_pk_bf16(w4.x, w4.y); q.y = cvt_pk_bf16(w4.z, w4.w); *(LAS u32x2*)(Wb + t * STR + s4 * 2) = q; } }
        __syncthreads();
#pragma unroll
        for (int i = 0; i < 8; ++i) { const int u = tid + 512 * i;
            if (u < R * 32) { const int s = prompt ? (u & 127) : (u & 63), c8 = (prompt ? (u >> 7) : (u >> 6)) * 8;
            const u32x4 q = vq[i]; const float mu = rs[2 * s], rstd = rs[2 * s + 1];
            const float* lg = p->ln_v_g + (size_t)l * D + cb + c8; const float* lbp = p->ln_v_b + (size_t)l * D + cb + c8;
            const f32x4 g0 = *(const f32x4*)lg, g1 = *(const f32x4*)(lg + 4), b0 = *(const f32x4*)lbp, b1 = *(const f32x4*)(lbp + 4);
            f32x4 x0 = (f32x4){bf_lo(q.x), bf_hi(q.x), bf_lo(q.y), bf_hi(q.y)}, x1 = (f32x4){bf_lo(q.z), bf_hi(q.z), bf_lo(q.w), bf_hi(q.w)};
            x0 = (x0 - mu) * rstd * g0 + b0; x1 = (x1 - mu) * rstd * g1 + b1;
            const unsigned pa = cvt_pk_bf16(x0.x, x0.y), pb = cvt_pk_bf16(x0.z, x0.w), pc = cvt_pk_bf16(x1.x, x1.y), pd = cvt_pk_bf16(x1.z, x1.w);
            LAS unsigned short* dst = (LAS unsigned short*)(vnT + c8 * STR + s * 2);
            dst[0] = (unsigned short)(pa & 0xffffu); dst[STR / 2] = (unsigned short)(pa >> 16); dst[2 * (STR / 2)] = (unsigned short)(pb & 0xffffu); dst[3 * (STR / 2)] = (unsigned short)(pb >> 16);
            dst[4 * (STR / 2)] = (unsigned short)(pc & 0xffffu); dst[5 * (STR / 2)] = (unsigned short)(pc >> 16); dst[6 * (STR / 2)] = (unsigned short)(pd & 0xffffu); dst[7 * (STR / 2)] = (unsigned short)(pd >> 16);
            if (!prompt) { float* vo = p->out + OUT_VS + ((size_t)(l * 32 + (cix - 256)) * 64 + s) * D + cb + c8; *(f32x4*)vo = x0; *(f32x4*)(vo + 4) = x1; } } }
        const int t0 = wave * 16, t = t0 + fr;
        bf16_t* urow = UZ + (size_t)(row0 + t) * D + cb + 4 * fq;
        u32x2 uzr[16]; float bias = 0.f;
        if (t0 < R) { bias = p->b_s[(size_t)(l * 4 + g) * 128 + t];
#pragma unroll
            for (int c = 0; c < 16; ++c) uzr[c] = *(const u32x2*)(urow + c * 16); }
        __syncthreads();
        if (t0 < R) {
            f32x4 acc[16];
#pragma unroll
            for (int c = 0; c < 16; ++c) acc[c] = (f32x4){0.f, 0.f, 0.f, 0.f};
            const int nsteps = (t0 + 15) / 32 + 1;
            for (int ks = 0; ks < nsteps; ++ks) { const int soff = (32 * ks + 8 * fq) * 2;
                const bf16x8 Bf = *(const LAS bf16x8*)(Wb + (t0 + fr) * STR + soff);
#pragma unroll
                for (int c = 0; c < 16; ++c) { const bf16x8 Af = *(const LAS bf16x8*)(vnT + (c * 16 + fr) * STR + soff); acc[c] = __builtin_amdgcn_mfma_f32_16x16x32_bf16(Af, Bf, acc[c], 0, 0, 0); } }
#pragma unroll
            for (int c = 0; c < 16; ++c) { const u32x2 uz = uzr[c];
                u32x2 w; w.x = cvt_pk_bf16(bf_lo(uz.x) * (acc[c].x + bias), bf_hi(uz.x) * (acc[c].y + bias)); w.y = cvt_pk_bf16(bf_lo(uz.y) * (acc[c].z + bias), bf_hi(uz.y) * (acc[c].w + bias));
                *(u32x2*)(urow + c * 16) = w; }
        }
    }
}

__device__ __forceinline__ void grid_barrier(unsigned* ctr, unsigned target) {
    asm volatile("s_waitcnt vmcnt(0)" ::: "memory");
    __syncthreads();
    if (threadIdx.x == 0) {
        __builtin_amdgcn_fence(__ATOMIC_RELEASE, "agent");
        asm volatile("s_waitcnt vmcnt(0)" ::: "memory");
        (void)__hip_atomic_fetch_add(ctr, 1u, __ATOMIC_RELAXED, __HIP_MEMORY_SCOPE_AGENT);
        unsigned sp = 0u;
        while (__hip_atomic_load(ctr, __ATOMIC_RELAXED, __HIP_MEMORY_SCOPE_AGENT) < target) { __builtin_amdgcn_s_sleep(1); if (++sp > (1u << 22)) break; }
        __builtin_amdgcn_fence(__ATOMIC_ACQUIRE, "agent");
        asm volatile("s_waitcnt vmcnt(0)" ::: "memory");
    }
    __syncthreads();
}

__global__ void __launch_bounds__(512) fwd_kernel(Params p_arg) {
    extern __shared__ __attribute__((aligned(16))) unsigned char shm[];
    LAS unsigned char* lds = (LAS unsigned char*)shm;
    const int ph_lo = p_arg.ph_lo, ph_hi = p_arg.ph_hi;
    for (int ph = ph_lo; ph < ph_hi; ++ph) {
        CParams* p = (CParams*)__builtin_amdgcn_kernarg_segment_ptr(); asm volatile("" : "+s"(p));
        unsigned char* ws = p->ws;
        bf16_t* B0 = (bf16_t*)(ws + WS_BUF); bf16_t* B1 = B0 + (size_t)M * D; bf16_t* B2 = B1 + (size_t)M * D; bf16_t* B3 = B2 + (size_t)M * D; bf16_t* B4 = B3 + (size_t)M * D; bf16_t* B5 = B4 + (size_t)M * D;
        float* xbuf = p->out + OUT_Y;
        const int G = ogrid(), bid = obid();
        if (ph == 0) { if (bid == 0 && threadIdx.x == 0) __hip_atomic_store((unsigned*)(ws + WS_BAR), 0u, __ATOMIC_RELAXED, __HIP_MEMORY_SCOPE_AGENT); phase_prep(p, lds); }
        else if (ph == 17) phase_final(p);
        else {
            const int l = (ph - 1) >> 3, sub = (ph - 1) & 7;
            const float* xp = l == 0 ? p->x_prompt : xbuf; const float* xs = l == 0 ? p->x_sample : xbuf + (size_t)MP * D;
            const bf16_t* WinT = (const bf16_t*)(ws + WS_WIN) + (size_t)l * NIN * D;
            pg8::StaticOrder S;
            if (sub == 0) phase_norm(p, l, xp, xs, B0);
            else if (sub == 1) { pg8::Gemm g{B0, WinT, M, NB_COLS, D}; S.init(M, NB_COLS, G, bid); EpiB E{B1, B2, B3, B5, B4};
                pg8::gemm_phase<EpiB, pg8::StaticOrder, true, true>(lds, g, S, E); }
            else if (sub == 2) phase_scan(p, l, B1, B2, B3, (float*)(ws + WS_STATS), lds);
            else if (sub == 3) phase_hnorm(p, l, B3, B1, B5, (const float*)(ws + WS_STATS));
            else if (sub == 4) {
                { pg8::Gemm g{B1, (const bf16_t*)(ws + WS_WPB) + (size_t)l * D * D, M, D, D}; S.init(M, D, G, bid); EpiGate<false> E{B4, nullptr, B4};
                  pg8::gemm_phase<EpiGate<false>, pg8::StaticOrder, true, true>(lds, g, S, E); }
                { pg8::Gemm g{B0, WinT + (size_t)NB_COLS * D, M, NA_COLS, D}; S.init(M, NA_COLS, G, G - 1 - bid); EpiA E{B3, B5, B2, (float*)(ws + WS_STATS)};
                  pg8::gemm_phase<EpiA, pg8::StaticOrder, true, true>(lds, g, S, E); } }
            else if (sub == 5) phase_gmlp(p, l, B3, B5, lds);
            else if (sub == 6) { pg8::Gemm g{B3, (const bf16_t*)(ws + WS_WPA) + (size_t)l * D * D, M, D, D}; S.init(M, D, G, bid); EpiGate<true> E{B2, B4, B5};
                pg8::gemm_phase<EpiGate<true>, pg8::StaticOrder, true, true>(lds, g, S, E); }
            else { pg8::Gemm g{B5, (const bf16_t*)(ws + WS_WO) + (size_t)l * D * D, M, D, D}; S.init(M, D, G, bid);
                EpiO E{xp, xs, xbuf, (const float*)(ws + WS_MOD) + (size_t)l * NCOND * 3 * D};
                pg8::gemm_phase<EpiO, pg8::StaticOrder, true, true>(lds, g, S, E); }
        }
#if MK_ONE_LAUNCH
        if (ph + 1 < ph_hi) { if (ph == 0) cg::this_grid().sync(); else grid_barrier((unsigned*)(ws + WS_BAR), (unsigned)ph * (unsigned)G); }
#endif
    }
}


extern "C" void kernel_launch(void* const* d_in, const int* in_sizes, int n_in, void* d_out, int out_size, void* d_ws, size_t ws_size, hipStream_t stream) {
    static int grid = 0;
    if (grid == 0) {
        if (n_in != 19 || ws_size < WS_END) { fprintf(stderr, "kernel_launch: need 19 inputs and %zu bytes of workspace; got %d, %zu\n", (size_t)WS_END, n_in, ws_size); grid = -1; return; }
        if (hipFuncSetAttribute((const void*)fwd_kernel, hipFuncAttributeMaxDynamicSharedMemorySize, LDS_BYTES) != hipSuccess) { fprintf(stderr, "kernel_launch: hipFuncSetAttribute failed\n"); grid = -1; return; }
        int dev = 0, cus = 0, per_cu = 0;
        hipGetDevice(&dev); hipDeviceGetAttribute(&cus, hipDeviceAttributeMultiprocessorCount, dev);
        hipOccupancyMaxActiveBlocksPerMultiprocessor(&per_cu, (const void*)fwd_kernel, 512, LDS_BYTES);
        if (per_cu < 1) { fprintf(stderr, "kernel_launch: occupancy query says %d blocks per CU\n", per_cu); per_cu = 1; }
        (void)hipGetLastError();
        grid = cus;
    }
    if (grid < 0) return;
    Params p{};
    const float** pp = (const float**)&p;
    for (int i = 0; i < 19; ++i) pp[i] = (const float*)d_in[i];
    p.out = (float*)d_out; p.ws = (unsigned char*)d_ws;
#if MK_ONE_LAUNCH
    p.ph_lo = 0; p.ph_hi = 18;
    void* args[] = {&p};
    hipError_t e = hipLaunchCooperativeKernel((const void*)fwd_kernel, dim3(grid), dim3(512), args, LDS_BYTES, stream);
    if (e != hipSuccess) fprintf(stderr, "cooperative launch failed: %s (grid %d)\n", hipGetErrorString(e), grid);
#else
    for (int ph = 0; ph < 18; ++ph) { p.ph_lo = ph; p.ph_hi = ph + 1; hipLaunchKernelGGL(fwd_kernel, dim3(grid), dim3(512), LDS_BYTES, stream, p); }
#endif
}
```
